# Optimizing an MI355X kernel written in HIP

```python
import jax, jax.numpy as jnp
from jax import lax
import numpy as np

D_MODEL = 1024
BATCH = 16
SEQ = 2048
DEPTH = 1

CHUNK = 64
PLE_DIM = 256
EPS = 1e-6

A_HEADS = 8
A_HEAD_DIM = 64
A_WIDTH = A_HEADS * A_HEAD_DIM
A_LOOKBACK = 8
A_BAND = A_LOOKBACK + 1
REL_CLIP = 128
N_REL = 2 * REL_CLIP + 1

B_HEADS = 4
B_KEY_DIM = 128
B_VAL_DIM = 128
B_QK_WIDTH = B_HEADS * B_KEY_DIM
B_V_WIDTH = B_HEADS * B_VAL_DIM
CONV_WIDTH = 4
B_CONV_CH = 2 * B_QK_WIDTH + B_V_WIDTH

D_FF = ((8 * D_MODEL // 3 + 255) // 256) * 256

N_BRANCH = 2
SPLIT_A = 3 * A_WIDTH
SPLIT_CONV = SPLIT_A + B_CONV_CH
SPLIT_Z = SPLIT_CONV + B_V_WIDTH
SPLIT_BETA = SPLIT_Z + B_HEADS
SPLIT_DECAY = SPLIT_BETA + B_HEADS
D_IN = SPLIT_DECAY + N_BRANCH * D_MODEL

kernel_name = "hybrid_chunked_attn_gated_deltanet_block"


def rmsnorm(x, g):
    xf = x.astype(jnp.float32)
    y = xf * lax.rsqrt(jnp.mean(xf * xf, axis=-1, keepdims=True) + EPS)
    return (y * g.astype(jnp.float32)).astype(x.dtype)


def l2norm(x):
    return x * lax.rsqrt(jnp.sum(x * x, axis=-1, keepdims=True) + EPS)


def causal_depthwise_conv(x, w):
    s = x.shape[1]
    k = w.shape[0]
    xp = jnp.pad(x, ((0, 0), (k - 1, 0), (0, 0)))
    out = xp[:, 0:s] * w[0]
    for i in range(1, k):
        out = out + xp[:, i:i + s] * w[i]
    return out


def chunked_band_attention(q, k, v, rel_bias):
    b, s, h, d = q.shape
    nc = s // CHUNK
    qc = q.reshape(b, nc, CHUNK, h, d) * (d ** -0.5)
    pad = ((0, 0), (A_LOOKBACK, 0), (0, 0), (0, 0), (0, 0))
    kc = jnp.pad(k.reshape(b, nc, CHUNK, h, d), pad)
    vc = jnp.pad(v.reshape(b, nc, CHUNK, h, d), pad)
    scores = jnp.stack(
        [jnp.einsum('bnqhd,bnkhd->bhnqk', qc, kc[:, j:j + nc]) for j in range(A_BAND)],
        axis=4)
    scores = scores.reshape(b, h, nc, CHUNK, A_BAND * CHUNK).astype(jnp.float32)
    qi = jnp.arange(CHUNK)
    kj = jnp.arange(A_BAND * CHUNK)
    rel = (A_LOOKBACK * CHUNK + qi[:, None]) - kj[None, :]
    idx = jnp.clip(rel, -REL_CLIP, REL_CLIP) + REL_CLIP
    bias = rel_bias[:, idx].astype(jnp.float32)
    valid = (jnp.arange(nc)[:, None] + jnp.arange(A_BAND)[None, :]) >= A_LOOKBACK
    valid = jnp.repeat(valid, CHUNK, axis=1)
    scores = jnp.where(valid[None, None, :, None, :], scores + bias[None, :, None], -1e30)
    probs = jax.nn.softmax(scores, axis=-1).astype(v.dtype)
    probs = probs.reshape(b, h, nc, CHUNK, A_BAND, CHUNK)
    out = jnp.einsum('bhnqk,bnkhd->bnqhd', probs[:, :, :, :, 0], vc[:, 0:nc])
    for j in range(1, A_BAND):
        out = out + jnp.einsum('bhnqk,bnkhd->bnqhd', probs[:, :, :, :, j], vc[:, j:j + nc])
    return out.reshape(b, s, h * d)


def gated_delta_rule(q, k, v, g, beta):
    out_dtype = v.dtype
    f32 = jnp.float32
    b, s, h, dk = q.shape
    dv = v.shape[-1]
    nc = s // CHUNK
    L = CHUNK

    def to_chunks(t):
        return jnp.moveaxis(t.reshape((b, nc, L, h) + t.shape[3:]), 3, 1)

    q = to_chunks(l2norm(q.astype(f32)) * (dk ** -0.5))
    k = to_chunks(l2norm(k.astype(f32)))
    v = to_chunks(v.astype(f32))
    g = to_chunks(g.astype(f32))
    beta = to_chunks(beta.astype(f32))

    gc = jnp.cumsum(g, axis=-1)
    ti = jnp.arange(L)
    tri_incl = ti[:, None] >= ti[None, :]
    tri_strict = ti[:, None] > ti[None, :]
    diff = gc[..., :, None] - gc[..., None, :]
    decay = jnp.exp(jnp.where(tri_incl, diff, -jnp.inf))
    kk = jnp.einsum('bhnid,bhnjd->bhnij', k, k)
    a_mat = jnp.where(tri_strict, beta[..., :, None] * kk * decay, 0.0)
    eye = jnp.eye(L, dtype=f32)
    rhs = jnp.concatenate([beta[..., None] * v,
                           (beta * jnp.exp(gc))[..., None] * k], axis=-1)
    sol = lax.linalg.triangular_solve(eye + a_mat, rhs, left_side=True,
                                      lower=True, unit_diagonal=True)
    u, wk = sol[..., :dv], sol[..., dv:]
    pqk = jnp.einsum('bhnid,bhnjd->bhnij', q, k) * decay
    gamma = jnp.exp(gc)
    g_last = gc[..., -1]
    kdec = k * jnp.exp(g_last[..., None] - gc)[..., None]

    def front(t):
        return jnp.moveaxis(t, 2, 0)

    xs = (front(u), front(wk), front(q), front(pqk), front(gamma), front(kdec), front(g_last))

    def step(state, inp):
        u_c, wk_c, q_c, p_c, gam_c, kd_c, gl_c = inp
        w = u_c - jnp.einsum('bhld,bhvd->bhlv', wk_c, state)
        o = gam_c[..., None] * jnp.einsum('bhld,bhvd->bhlv', q_c, state) \
            + jnp.einsum('bhts,bhsv->bhtv', p_c, w)
        state = jnp.exp(gl_c)[..., None, None] * state + jnp.einsum('bhlv,bhld->bhvd', w, kd_c)
        return state, o

    s0 = jnp.zeros((b, h, dv, dk), f32)
    _, o = lax.scan(step, s0, xs)
    o = jnp.transpose(o, (1, 0, 3, 2, 4)).reshape(b, s, h, dv)
    return o.astype(out_dtype)


def setup_inputs(seed: int = 0) -> dict:
    key = jax.random.key(seed)
    ks = jax.random.split(key, 24)
    f32 = jnp.float32

    def nrm(k, shape, scale):
        return jax.random.normal(k, shape, f32) * scale

    def gain(k, shape):
        return 1.0 + 0.1 * jax.random.normal(k, shape, f32)

    x = jax.random.normal(ks[0], (BATCH, SEQ, D_MODEL), f32)
    p = jax.random.normal(ks[1], (DEPTH, BATCH, SEQ, PLE_DIM), f32)
    g_mix = gain(ks[2], (DEPTH, D_MODEL))
    w_in = nrm(ks[3], (DEPTH, D_MODEL, D_IN), D_MODEL ** -0.5)
    conv_w = nrm(ks[4], (DEPTH, CONV_WIDTH, B_CONV_CH), CONV_WIDTH ** -0.5)
    a_log = jnp.log(jax.random.uniform(ks[5], (DEPTH, B_HEADS), f32, 1.0, 16.0))
    dt = jnp.exp(jax.random.uniform(ks[6], (DEPTH, B_HEADS), f32,
                                    np.log(1e-3), np.log(1e-1)))
    dt_bias = dt + jnp.log(-jnp.expm1(-dt))
    rel_bias = nrm(ks[7], (DEPTH, A_HEADS, N_REL), 0.1)
    w_onorm = gain(ks[8], (DEPTH, B_VAL_DIM))
    w_branch_a = nrm(ks[9], (DEPTH, A_WIDTH, D_MODEL), A_WIDTH ** -0.5)
    w_branch_b = nrm(ks[10], (DEPTH, B_V_WIDTH, D_MODEL), B_V_WIDTH ** -0.5)
    w_out = nrm(ks[11], (DEPTH, D_MODEL, D_MODEL), D_MODEL ** -0.5)
    g_ffn = gain(ks[12], (DEPTH, D_MODEL))
    w_gate_up = nrm(ks[13], (DEPTH, D_MODEL, 2 * D_FF), D_MODEL ** -0.5)
    w_down = nrm(ks[14], (DEPTH, D_FF, D_MODEL), D_FF ** -0.5)
    g_ple = gain(ks[15], (DEPTH, D_MODEL))
    w_ple_gate = nrm(ks[16], (DEPTH, D_MODEL, D_MODEL), D_MODEL ** -0.5)
    w_ple_proj = nrm(ks[17], (DEPTH, PLE_DIM, D_MODEL), PLE_DIM ** -0.5)
    g_final = gain(ks[18], (D_MODEL,))
    return {"x": x, "p": p, "g_mix": g_mix, "w_in": w_in, "conv_w": conv_w,
            "a_log": a_log, "dt_bias": dt_bias, "rel_bias": rel_bias, "w_onorm": w_onorm,
            "w_branch_a": w_branch_a, "w_branch_b": w_branch_b, "w_out": w_out,
            "g_ffn": g_ffn, "w_gate_up": w_gate_up, "w_down": w_down,
            "g_ple": g_ple, "w_ple_gate": w_ple_gate, "w_ple_proj": w_ple_proj,
            "g_final": g_final}


def reference(x, p, g_mix, w_in, conv_w, a_log, dt_bias, rel_bias, w_onorm,
              w_branch_a, w_branch_b, w_out, g_ffn, w_gate_up, w_down,
              g_ple, w_ple_gate, w_ple_proj, g_final):
    b, s, _ = x.shape
    for i in range(DEPTH):
        h = rmsnorm(x, g_mix[i])
        proj = h @ w_in[i]
        qkv_a = proj[..., :SPLIT_A]
        conv_in = proj[..., SPLIT_A:SPLIT_CONV]
        z = proj[..., SPLIT_CONV:SPLIT_Z]
        beta_raw = proj[..., SPLIT_Z:SPLIT_BETA]
        decay_raw = proj[..., SPLIT_BETA:SPLIT_DECAY]
        gates = proj[..., SPLIT_DECAY:]

        q_a = qkv_a[..., :A_WIDTH].reshape(b, s, A_HEADS, A_HEAD_DIM)
        k_a = qkv_a[..., A_WIDTH:2 * A_WIDTH].reshape(b, s, A_HEADS, A_HEAD_DIM)
        v_a = qkv_a[..., 2 * A_WIDTH:].reshape(b, s, A_HEADS, A_HEAD_DIM)
        y_a = chunked_band_attention(q_a, k_a, v_a, rel_bias[i])

        c = jax.nn.silu(causal_depthwise_conv(conv_in, conv_w[i]))
        q_b = c[..., :B_QK_WIDTH].reshape(b, s, B_HEADS, B_KEY_DIM)
        k_b = c[..., B_QK_WIDTH:2 * B_QK_WIDTH].reshape(b, s, B_HEADS, B_KEY_DIM)
        v_b = c[..., 2 * B_QK_WIDTH:].reshape(b, s, B_HEADS, B_VAL_DIM)
        beta = jax.nn.sigmoid(beta_raw)
        g = -jnp.exp(a_log[i]) * jax.nn.softplus(decay_raw + dt_bias[i])
        o_b = gated_delta_rule(q_b, k_b, v_b, g, beta)
        o_b = rmsnorm(o_b, w_onorm[i]) * jax.nn.silu(z.reshape(b, s, B_HEADS, B_VAL_DIM))
        y_b = o_b.reshape(b, s, B_V_WIDTH)

        gate_a = jax.nn.sigmoid(gates[..., :D_MODEL])
        gate_b = jax.nn.sigmoid(gates[..., D_MODEL:])
        merged = gate_a * (y_a @ w_branch_a[i]) + gate_b * (y_b @ w_branch_b[i])
        x = x + merged @ w_out[i]

        h = rmsnorm(x, g_ffn[i])
        gu = h @ w_gate_up[i]
        x = x + (jax.nn.silu(gu[..., :D_FF]) * gu[..., D_FF:]) @ w_down[i]

        ple_gate = jax.nn.sigmoid(rmsnorm(x, g_ple[i]) @ w_ple_gate[i])
        x = x + ple_gate * (p[i] @ w_ple_proj[i])
    return rmsnorm(x, g_final)
```

```cpp
#include <hip/hip_runtime.h>
#include <cstdio>
#include <cstdint>

#ifndef MK_N_LAUNCHES
#define MK_N_LAUNCHES 1
#endif

__device__ __forceinline__ int lane_id() { int l; asm volatile("v_mbcnt_lo_u32_b32 %0, -1, 0\n\tv_mbcnt_hi_u32_b32 %0, -1, %0" : "=v"(l)); return l; }
namespace pg8 {
#define PG8_LAS __attribute__((address_space(3)))
typedef unsigned short bf16_t;
typedef short bf16x8 __attribute__((ext_vector_type(8)));
typedef float f32x4 __attribute__((ext_vector_type(4)));
typedef unsigned u32x4 __attribute__((ext_vector_type(4)));
constexpr int BM = 256, BK = 64, HALF = 128, HTB = HALF * BK * 2, STAGE_BYTES = 8 * HTB, NXCD = 8, WGM = 8;

__host__ __device__ __forceinline__ int lds_byte(int r, int c) { const int st = (r >> 4) * 2 + (c >> 5), rr = r & 15, cc = c & 31, ob = rr * 64 + cc * 2; return st * 1024 + (ob ^ (((ob >> 9) & 1) << 5)); }
__host__ __device__ __forceinline__ void stage_rc(int b, int& R, int& C) { const int st = b / 1024, sb = b % 1024, swz = sb ^ (((sb >> 9) & 1) << 5); R = (st >> 1) * 16 + swz / 64; C = (st & 1) * 32 + (swz % 64) / 2; }
__host__ __device__ __forceinline__ int perm32(int rho) { const int n = rho >> 4, i = rho & 15; return 8 * (i >> 2) + 4 * n + (i & 3); }

struct Unit { int pm, pn, idx; };
struct Gemm { const bf16_t* A; const bf16_t* Bt; int M, N, K, lda, ldb; };

struct StaticOrder {
    int nM, nN, nwg, G, c;
    __host__ __device__ void init(int M, int N, int G_, int c_) { nM = M / BM; nN = N / BM; nwg = nM * nN; G = G_; c = c_; }
    __host__ __device__ bool next(int i, Unit& u) const {
        const long L = (long)i * G + c; if (L >= nwg) return false;
        int wgid = (int)L; { const int q = nwg / NXCD, r = nwg % NXCD, xcd = wgid % NXCD, off = wgid / NXCD; wgid = (xcd < r ? xcd * (q + 1) : r * (q + 1) + (xcd - r) * q) + off; }
        const int nig = WGM * nN, gid = wgid / nig, fm = gid * WGM, gsz = (nM - fm) < WGM ? (nM - fm) : WGM;
        u.pm = fm + ((wgid % nig) % gsz); u.pn = (wgid % nig) / gsz; u.idx = i; return true;
    }
    __device__ __forceinline__ void a_ready(const Unit&) const {}
    __device__ __forceinline__ void done(const Unit&) const {}
};

__device__ __forceinline__ unsigned cvt_pk_bf16(float lo, float hi) { unsigned r; asm volatile("v_cvt_pk_bf16_f32 %0, %1, %2" : "=v"(r) : "v"(lo), "v"(hi)); return r; }
__device__ __forceinline__ float bf_lo(unsigned u) { return __uint_as_float(u << 16); }
__device__ __forceinline__ float bf_hi(unsigned u) { return __uint_as_float(u & 0xffff0000u); }
__device__ __forceinline__ float sigm(float x) { return __builtin_amdgcn_rcpf(1.0f + __builtin_amdgcn_exp2f(-1.4426950408889634f * x)); }
__device__ __forceinline__ void st16_wt(void* p, u32x4 v) { asm volatile("global_store_dwordx4 %0, %1, off sc1\n\ts_nop 1" :: "v"(p), "v"(v) : "memory"); }
__device__ __forceinline__ u32x4 pack8(const f32x4 a, const f32x4 b) { u32x4 w; w.x = cvt_pk_bf16(a[0], a[1]); w.y = cvt_pk_bf16(a[2], a[3]); w.z = cvt_pk_bf16(b[0], b[1]); w.w = cvt_pk_bf16(b[2], b[3]); return w; }
__device__ __forceinline__ void unpack8(const u32x4 w, f32x4& a, f32x4& b) { a = (f32x4){bf_lo(w.x), bf_hi(w.x), bf_lo(w.y), bf_hi(w.y)}; b = (f32x4){bf_lo(w.z), bf_hi(w.z), bf_lo(w.w), bf_hi(w.w)}; }
__device__ __forceinline__ float rstd_from(const float* ssq, int row) {
    const f32x4* p = (const f32x4*)(ssq + (size_t)row * 16);
    const f32x4 a = p[0], b = p[1], c = p[2], d = p[3];
    const float s = ((a[0] + a[1]) + (a[2] + a[3])) + ((b[0] + b[1]) + (b[2] + b[3])) + ((c[0] + c[1]) + (c[2] + c[3])) + ((d[0] + d[1]) + (d[2] + d[3]));
    return __builtin_amdgcn_rsqf(s * (1.0f / 1024.0f) + 1e-6f);
}

__device__ __forceinline__ float fq_sum(float v) {
    { const auto r = __builtin_amdgcn_permlane16_swap(__float_as_uint(v), __float_as_uint(v), false, false); v = __uint_as_float(r[0]) + __uint_as_float(r[1]); }
    { const auto r = __builtin_amdgcn_permlane32_swap(__float_as_uint(v), __float_as_uint(v), false, false); v = __uint_as_float(r[0]) + __uint_as_float(r[1]); }
    return v;
}
__device__ __forceinline__ void rstd8(const float* ssq, int row0, int fq, float (&r)[8]) {
    f32x4 p[8];
#pragma unroll
    for (int k = 0; k < 8; ++k) p[k] = *(const f32x4*)(ssq + (size_t)(row0 + (k >> 2) * HALF + (k & 3) * 16) * 16 + 4 * fq);
#pragma unroll
    for (int k = 0; k < 8; ++k) r[k] = __builtin_amdgcn_rsqf(fq_sum((p[k][0] + p[k][1]) + (p[k][2] + p[k][3])) * (1.0f / 1024.0f) + 1e-6f);
}
struct EpiBf16 {
    static constexpr bool PERM = true, AFTER_DRAIN = false, HAS_MID = false;
    bf16_t* O; int ldc;
    __device__ __forceinline__ void operator()(const f32x4 (&acc)[2][2][4][2], const Unit& u, int wr, int wc, int fr, int fq) const {
        const int row0 = u.pm * BM + wr * 64 + fr; const int col0 = u.pn * BM + wc * 32 + 8 * fq;
#pragma unroll
        for (int ai = 0; ai < 2; ++ai)
#pragma unroll
            for (int m = 0; m < 4; ++m) { bf16_t* rowp = O + (size_t)(row0 + ai * HALF + m * 16) * ldc + col0;
#pragma unroll
                for (int bj = 0; bj < 2; ++bj) *(u32x4*)(rowp + bj * HALF) = pack8(acc[ai][bj][m][0], acc[ai][bj][m][1]); }
    }
};
struct EpiGate {
    static constexpr bool PERM = true, AFTER_DRAIN = false, HAS_MID = false;
    bf16_t* O; int ldc; const float* wn;
    __device__ __forceinline__ void operator()(const f32x4 (&acc)[2][2][4][2], const Unit& u, int wr, int wc, int fr, int fq) const {
        const int row0 = u.pm * BM + wr * 64 + fr; const int col0 = u.pn * BM + wc * 32 + 8 * fq;
#pragma unroll
        for (int bj = 0; bj < 2; ++bj) { const f32x4 g0 = *(const f32x4*)(wn + ((col0 + bj * HALF) & 127)), g1 = *(const f32x4*)(wn + ((col0 + bj * HALF) & 127) + 4);
#pragma unroll
            for (int ai = 0; ai < 2; ++ai)
#pragma unroll
                for (int m = 0; m < 4; ++m) { f32x4 v0 = acc[ai][bj][m][0], v1 = acc[ai][bj][m][1];
#pragma unroll
                    for (int i = 0; i < 4; ++i) { v0[i] = v0[i] * sigm(v0[i]) * g0[i]; v1[i] = v1[i] * sigm(v1[i]) * g1[i]; }
                    *(u32x4*)(O + (size_t)(row0 + ai * HALF + m * 16) * ldc + col0 + bj * HALF) = pack8(v0, v1); } }
    }
};
struct EpiMergeF {
    static constexpr bool PERM = true, AFTER_DRAIN = false, HAS_MID = true;
    const bf16_t* ga; const bf16_t* gb; int ldg; bf16_t* OUT;
    __device__ __forceinline__ void mid(f32x4 (&acc)[2][2][4][2], const Unit& u, int wr, int wc, int fr, int fq) const {
        int opq = 0; asm volatile("" : "+v"(opq));
        const int row0 = u.pm * BM + wr * 64 + fr + opq; const int col0 = u.pn * BM + wc * 32 + 8 * fq;
#pragma unroll
        for (int ai = 0; ai < 2; ++ai) {
            u32x4 aw[4][2], bw[4][2];
#pragma unroll
            for (int m = 0; m < 4; ++m)
#pragma unroll
                for (int bj = 0; bj < 2; ++bj) { const size_t o = (size_t)(row0 + ai * HALF + m * 16) * ldg + col0 + bj * HALF; aw[m][bj] = *(const u32x4*)(ga + o); bw[m][bj] = *(const u32x4*)(gb + o); }
#pragma unroll
            for (int m = 0; m < 4; ++m)
#pragma unroll
                for (int bj = 0; bj < 2; ++bj) { f32x4 a0, a1, b0, b1; unpack8(aw[m][bj], a0, a1); unpack8(bw[m][bj], b0, b1);
#pragma unroll
                    for (int i = 0; i < 4; ++i) {
                        acc[ai][bj][m][0][i] *= (1.0f + __builtin_amdgcn_exp2f(-1.4426950408889634f * b0[i])) * __builtin_amdgcn_rcpf(1.0f + __builtin_amdgcn_exp2f(-1.4426950408889634f * a0[i]));
                        acc[ai][bj][m][1][i] *= (1.0f + __builtin_amdgcn_exp2f(-1.4426950408889634f * b1[i])) * __builtin_amdgcn_rcpf(1.0f + __builtin_amdgcn_exp2f(-1.4426950408889634f * a1[i])); } }
        }
    }
    __device__ __forceinline__ void operator()(const f32x4 (&acc)[2][2][4][2], const Unit& u, int wr, int wc, int fr, int fq) const {
        const int row0 = u.pm * BM + wr * 64 + fr; const int col0 = u.pn * BM + wc * 32 + 8 * fq;
        u32x4 bw[2][4][2];
#pragma unroll
        for (int ai = 0; ai < 2; ++ai)
#pragma unroll
            for (int m = 0; m < 4; ++m)
#pragma unroll
                for (int bj = 0; bj < 2; ++bj) bw[ai][m][bj] = *(const u32x4*)(gb + (size_t)(row0 + ai * HALF + m * 16) * ldg + col0 + bj * HALF);
#pragma unroll
        for (int ai = 0; ai < 2; ++ai)
#pragma unroll
            for (int m = 0; m < 4; ++m)
#pragma unroll
                for (int bj = 0; bj < 2; ++bj) { f32x4 b0, b1; unpack8(bw[ai][m][bj], b0, b1); f32x4 v0 = acc[ai][bj][m][0], v1 = acc[ai][bj][m][1];
#pragma unroll
                    for (int i = 0; i < 4; ++i) { v0[i] *= sigm(b0[i]); v1[i] *= sigm(b1[i]); }
                    bw[ai][m][bj] = pack8(v0, v1); }
#pragma unroll
        for (int ai = 0; ai < 2; ++ai)
#pragma unroll
            for (int m = 0; m < 4; ++m)
#pragma unroll
                for (int bj = 0; bj < 2; ++bj) *(u32x4*)(OUT + (size_t)(row0 + ai * HALF + m * 16) * 1024 + col0 + bj * HALF) = bw[ai][m][bj];
    }
};
template <bool BASE_BF16> struct EpiRes {
    static constexpr bool PERM = true, AFTER_DRAIN = false, HAS_MID = false;
    const float* base; const bf16_t* baseb; bf16_t* outb; float* ssq; unsigned* cnt;
    __device__ __forceinline__ void operator()(const f32x4 (&acc)[2][2][4][2], const Unit& u, int wr, int wc, int fr, int fq) const {
        const int row0 = u.pm * BM + wr * 64 + fr; const int col0 = u.pn * BM + wc * 32 + 8 * fq;
        if constexpr (BASE_BF16) {
            u32x4 w[2][4][2]; float ss[8];
#pragma unroll
            for (int ai = 0; ai < 2; ++ai)
#pragma unroll
                for (int m = 0; m < 4; ++m)
#pragma unroll
                    for (int bj = 0; bj < 2; ++bj) w[ai][m][bj] = *(const u32x4*)(baseb + (size_t)(row0 + ai * HALF + m * 16) * 1024 + col0 + bj * HALF);
#pragma unroll
            for (int ai = 0; ai < 2; ++ai)
#pragma unroll
                for (int m = 0; m < 4; ++m) { float s = 0.f;
#pragma unroll
                    for (int bj = 0; bj < 2; ++bj) { f32x4 v0, v1; unpack8(w[ai][m][bj], v0, v1); v0 += acc[ai][bj][m][0]; v1 += acc[ai][bj][m][1]; w[ai][m][bj] = pack8(v0, v1);
                        s += (v0[0] * v0[0] + v0[1] * v0[1]) + (v0[2] * v0[2] + v0[3] * v0[3]) + (v1[0] * v1[0] + v1[1] * v1[1]) + (v1[2] * v1[2] + v1[3] * v1[3]); }
                    ss[ai * 4 + m] = fq_sum(s); }
#pragma unroll
            for (int ai = 0; ai < 2; ++ai)
#pragma unroll
                for (int m = 0; m < 4; ++m) { const size_t row = (size_t)(row0 + ai * HALF + m * 16);
#pragma unroll
                    for (int bj = 0; bj < 2; ++bj) { if (cnt) st16_wt(outb + row * 1024 + col0 + bj * HALF, w[ai][m][bj]); else *(u32x4*)(outb + row * 1024 + col0 + bj * HALF) = w[ai][m][bj]; }
                    if (fq == 0) { if (cnt) __hip_atomic_store(ssq + row * 16 + u.pn * 4 + wc, ss[ai * 4 + m], __ATOMIC_RELAXED, __HIP_MEMORY_SCOPE_AGENT); else ssq[row * 16 + u.pn * 4 + wc] = ss[ai * 4 + m]; } }
            if (cnt) {
                asm volatile("s_waitcnt vmcnt(0)" ::: "memory"); __builtin_amdgcn_s_barrier(); asm volatile("" ::: "memory");
                if (wr == 0 && wc == 0 && lane_id() == 0) __hip_atomic_fetch_add(cnt + 64 * u.pm, 1u, __ATOMIC_RELAXED, __HIP_MEMORY_SCOPE_AGENT);
            }
        } else {
#pragma unroll
            for (int ai = 0; ai < 2; ++ai) {
                f32x4 b[4][2][2]; u32x4 w[4][2]; float ss[4];
#pragma unroll
                for (int m = 0; m < 4; ++m)
#pragma unroll
                    for (int bj = 0; bj < 2; ++bj) { const float* p = base + (size_t)(row0 + ai * HALF + m * 16) * 1024 + col0 + bj * HALF; b[m][bj][0] = __builtin_nontemporal_load((const f32x4*)p); b[m][bj][1] = __builtin_nontemporal_load((const f32x4*)(p + 4)); }
#pragma unroll
                for (int m = 0; m < 4; ++m) { float s = 0.f;
#pragma unroll
                    for (int bj = 0; bj < 2; ++bj) { const f32x4 v0 = b[m][bj][0] + acc[ai][bj][m][0], v1 = b[m][bj][1] + acc[ai][bj][m][1]; w[m][bj] = pack8(v0, v1);
                        s += (v0[0] * v0[0] + v0[1] * v0[1]) + (v0[2] * v0[2] + v0[3] * v0[3]) + (v1[0] * v1[0] + v1[1] * v1[1]) + (v1[2] * v1[2] + v1[3] * v1[3]); }
                    ss[m] = fq_sum(s); }
#pragma unroll
                for (int m = 0; m < 4; ++m) { const size_t row = (size_t)(row0 + ai * HALF + m * 16);
#pragma unroll
                    for (int bj = 0; bj < 2; ++bj) *(u32x4*)(outb + row * 1024 + col0 + bj * HALF) = w[m][bj];
                    if (fq == 0) ssq[row * 16 + u.pn * 4 + wc] = ss[m]; }
            }
        }
    }
};
struct EpiSwiglu {
    static constexpr bool PERM = true, AFTER_DRAIN = false, HAS_MID = false;
    const PG8_LAS float* rtab; bf16_t* H; int ldh;
    __device__ __forceinline__ void operator()(const f32x4 (&acc)[2][2][4][2], const Unit& u, int wr, int wc, int fr, int fq) const {
        const int row0 = u.pm * BM + wr * 64 + fr; const int col0 = u.pn * HALF + wc * 32 + 8 * fq;
        float r[8];
#pragma unroll
        for (int k = 0; k < 8; ++k) r[k] = rtab[u.idx * 256 + wr * 64 + fr + (k >> 2) * HALF + (k & 3) * 16];
        u32x4 w[8];
#pragma unroll
        for (int k = 0; k < 8; ++k) { const int ai = k >> 2, m = k & 3; f32x4 h0, h1;
#pragma unroll
            for (int i = 0; i < 4; ++i) { const float g0 = acc[ai][0][m][0][i] * r[k], g1 = acc[ai][0][m][1][i] * r[k];
                h0[i] = g0 * sigm(g0) * (acc[ai][1][m][0][i] * r[k]); h1[i] = g1 * sigm(g1) * (acc[ai][1][m][1][i] * r[k]); }
            w[k] = pack8(h0, h1); }
#pragma unroll
        for (int k = 0; k < 8; ++k) *(u32x4*)(H + (size_t)(row0 + (k >> 2) * HALF + (k & 3) * 16) * ldh + col0) = w[k];
    }
};
struct EpiPle {
    static constexpr bool PERM = true, AFTER_DRAIN = false, HAS_MID = false;
    const float* ssq; const bf16_t* base; const bf16_t* PP; bf16_t* out;
    __device__ __forceinline__ void operator()(const f32x4 (&acc)[2][2][4][2], const Unit& u, int wr, int wc, int fr, int fq) const {
        const int row0 = u.pm * BM + wr * 64 + fr; const int col0 = u.pn * BM + wc * 32 + 8 * fq;
#pragma unroll
        for (int ai = 0; ai < 2; ++ai)
#pragma unroll
            for (int m = 0; m < 4; ++m) { const int row = row0 + ai * HALF + m * 16; const float r = rstd_from(ssq, row);
#pragma unroll
                for (int bj = 0; bj < 2; ++bj) { const size_t off = (size_t)row * 1024 + col0 + bj * HALF;
                    const u32x4 pw = *(const u32x4*)(PP + off); f32x4 p0, p1; unpack8(pw, p0, p1);
                    const u32x4 bw = *(const u32x4*)(base + off); f32x4 v0, v1; unpack8(bw, v0, v1);
#pragma unroll
                    for (int i = 0; i < 4; ++i) { v0[i] += sigm(acc[ai][bj][m][0][i] * r) * p0[i]; v1[i] += sigm(acc[ai][bj][m][1][i] * r) * p1[i]; }
                    *(u32x4*)(out + off) = pack8(v0, v1); } }
    }
};

struct EpiPleNorm {
    static constexpr bool PERM = true, AFTER_DRAIN = false, HAS_MID = false;
    const float* ssq2; const bf16_t* base; const bf16_t* PP; float* out; float* ssq3; unsigned* cnt; const float* gfin;
    __device__ __forceinline__ void operator()(f32x4 (&acc)[2][2][4][2], const Unit& u, int wr, int wc, int fr, int fq) const {
        const int row0 = u.pm * BM + wr * 64 + fr; const int col0 = u.pn * BM + wc * 32 + 8 * fq;
        float r2[8], ss[8];
        u32x4 pw[4][2], bw[4][2];
        {
            f32x4 pr[8];
#pragma unroll
            for (int k = 0; k < 8; ++k) pr[k] = *(const f32x4*)(ssq2 + (size_t)(row0 + (k >> 2) * HALF + (k & 3) * 16) * 16 + 4 * fq);
#pragma unroll
            for (int m = 0; m < 4; ++m)
#pragma unroll
                for (int bj = 0; bj < 2; ++bj) { const size_t off = (size_t)(row0 + m * 16) * 1024 + col0 + bj * HALF; pw[m][bj] = *(const u32x4*)(PP + off); bw[m][bj] = *(const u32x4*)(base + off); }
#pragma unroll
            for (int k = 0; k < 8; ++k) r2[k] = __builtin_amdgcn_rsqf(fq_sum((pr[k][0] + pr[k][1]) + (pr[k][2] + pr[k][3])) * (1.0f / 1024.0f) + 1e-6f);
        }
#pragma unroll
        for (int ai = 0; ai < 2; ++ai) {
            if (ai == 1) {
#pragma unroll
                for (int m = 0; m < 4; ++m)
#pragma unroll
                    for (int bj = 0; bj < 2; ++bj) { const size_t off = (size_t)(row0 + HALF + m * 16) * 1024 + col0 + bj * HALF; pw[m][bj] = *(const u32x4*)(PP + off); bw[m][bj] = *(const u32x4*)(base + off); } }
#pragma unroll
            for (int m = 0; m < 4; ++m) { const float r = r2[ai * 4 + m]; float s = 0.f;
#pragma unroll
                for (int bj = 0; bj < 2; ++bj) { f32x4 p0, p1, v0, v1; unpack8(pw[m][bj], p0, p1); unpack8(bw[m][bj], v0, v1);
#pragma unroll
                    for (int i = 0; i < 4; ++i) { v0[i] += sigm(acc[ai][bj][m][0][i] * r) * p0[i]; v1[i] += sigm(acc[ai][bj][m][1][i] * r) * p1[i]; }
                    acc[ai][bj][m][0] = v0; acc[ai][bj][m][1] = v1;
                    s += (v0[0] * v0[0] + v0[1] * v0[1]) + (v0[2] * v0[2] + v0[3] * v0[3]) + (v1[0] * v1[0] + v1[1] * v1[1]) + (v1[2] * v1[2] + v1[3] * v1[3]); }
                ss[ai * 4 + m] = fq_sum(s); }
        }
        if (fq == 0) {
#pragma unroll
            for (int k = 0; k < 8; ++k) __hip_atomic_store(ssq3 + (size_t)(row0 + (k >> 2) * HALF + (k & 3) * 16) * 16 + u.pn * 4 + wc, ss[k], __ATOMIC_RELAXED, __HIP_MEMORY_SCOPE_AGENT); }
        asm volatile("s_waitcnt vmcnt(0)" ::: "memory");
        __builtin_amdgcn_s_barrier(); asm volatile("" ::: "memory");
        if (wr == 0 && wc == 0) {
            unsigned* c = cnt + 64 * u.pm;
            if (lane_id() == 0) __hip_atomic_fetch_add(c, 1u, __ATOMIC_RELAXED, __HIP_MEMORY_SCOPE_AGENT);
            unsigned sp = 0;
            while ((unsigned)__builtin_amdgcn_readfirstlane(__hip_atomic_load(c, __ATOMIC_RELAXED, __HIP_MEMORY_SCOPE_AGENT)) < 4u) { __builtin_amdgcn_s_sleep(2); if (++sp > (1u << 20)) break; }
            __builtin_amdgcn_fence(__ATOMIC_ACQUIRE, "agent");
            asm volatile("s_waitcnt vmcnt(0)" ::: "memory");
        }
        __builtin_amdgcn_s_barrier(); asm volatile("" ::: "memory");
        f32x4 g0[2], g1[2];
#pragma unroll
        for (int bj = 0; bj < 2; ++bj) { g0[bj] = *(const f32x4*)(gfin + col0 + bj * HALF); g1[bj] = *(const f32x4*)(gfin + col0 + bj * HALF + 4); }
        int opq = 0; asm volatile("" : "+v"(opq)); const int row1 = row0 + opq;
        float r3[8]; rstd8(ssq3, row1, fq, r3);
#pragma unroll
        for (int ai = 0; ai < 2; ++ai)
#pragma unroll
            for (int m = 0; m < 4; ++m) { const size_t row = (size_t)(row1 + ai * HALF + m * 16); const float r = r3[ai * 4 + m];
#pragma unroll
                for (int bj = 0; bj < 2; ++bj) { const size_t off = row * 1024 + col0 + bj * HALF;
                    *(f32x4*)(out + off) = acc[ai][bj][m][0] * r * g0[bj]; *(f32x4*)(out + off + 4) = acc[ai][bj][m][1] * r * g1[bj]; } }
    }
};

template <class Epi, class Sched, bool ALIGN_EPI = false, bool SP2 = false>
__device__ __forceinline__ void gemm_phase(PG8_LAS unsigned char* lds, const Gemm g, const Sched& S, const Epi& E, int wid) {
    const int lane = lane_id(), tid = wid * 64 + lane, wr = wid >> 2, wc = wid & 3, fr = lane & 15, fq = lane >> 4;
    const int K = g.K, nt = K / BK;
    unsigned voffA[2], voffB[2];
#pragma unroll
    for (int i = 0; i < 2; ++i) { int R, C; stage_rc(tid * 16 + i * 8192, R, C); const int Rb = Epi::PERM ? ((R & ~31) + perm32(R & 31)) : R;
        voffA[i] = (unsigned)(R * g.lda + C) * 2u; voffB[i] = (unsigned)(Rb * g.ldb + C) * 2u; }
    const size_t kstep = (size_t)(BK * 2);
    const size_t hstepA = (size_t)HALF * g.lda * 2, hstepB = (size_t)HALF * g.ldb * 2;
    const size_t tstepA = 2 * hstepA, tstepB = 2 * hstepB;
    const unsigned ldsw = (unsigned)wid * 1024u;
    const int aoff = lds_byte(wr * 64 + fr, fq * 8), boff = lds_byte(wc * 32 + fr, fq * 8);
#define PG8_SA(b, h) (((b) * 2 + (h)) * HTB)
#define PG8_SB(b, h) ((4 + (b) * 2 + (h)) * HTB)
#define PG8_STAGE(bufoff, gbase, voff) do { _Pragma("unroll") for (int _i = 0; _i < 2; ++_i) \
        __builtin_amdgcn_global_load_lds((const unsigned*)((const char*)(gbase) + (voff)[_i]), (PG8_LAS unsigned*)(lds + (bufoff) + ldsw + _i * 8192), 16, 0, 0); } while (0)
#define PG8_LDA(dst, b, h) do { _Pragma("unroll") for (int m = 0; m < 4; ++m) _Pragma("unroll") for (int k = 0; k < 2; ++k) dst[m][k] = *(const PG8_LAS bf16x8*)(lds + PG8_SA(b, h) + aoff + m * 2048 + k * 1024); } while (0)
#define PG8_LDB(dst, b, h) do { _Pragma("unroll") for (int n = 0; n < 2; ++n) _Pragma("unroll") for (int k = 0; k < 2; ++k) dst[n][k] = *(const PG8_LAS bf16x8*)(lds + PG8_SB(b, h) + boff + n * 2048 + k * 1024); } while (0)
#define PG8_MMA(ai, bj, At, Bt) do { __builtin_amdgcn_s_setprio(1); _Pragma("unroll") for (int m = 0; m < 4; ++m) _Pragma("unroll") for (int n = 0; n < 2; ++n) _Pragma("unroll") for (int k = 0; k < 2; ++k) \
        acc[ai][bj][m][n] = __builtin_amdgcn_mfma_f32_16x16x32_bf16(Bt[n][k], At[m][k], acc[ai][bj][m][n], 0, 0, 0); __builtin_amdgcn_s_setprio(0); } while (0)
#define PG8_WAIT_V(n) asm volatile("s_waitcnt vmcnt(" #n ")" ::: "memory")
#define PG8_WAIT_L(n) asm volatile("s_waitcnt lgkmcnt(" #n ")" ::: "memory")
#define PG8_BAR __builtin_amdgcn_s_barrier()
#define PG8_SCHED __builtin_amdgcn_sched_barrier(0)
    Unit cur, nxt; int ui = 0;
    if (!S.next(0, cur)) return;
    f32x4 acc[2][2][4][2];
#pragma unroll
    for (int a = 0; a < 2; ++a)
#pragma unroll
        for (int b = 0; b < 2; ++b)
#pragma unroll
            for (int m = 0; m < 4; ++m)
#pragma unroll
                for (int n = 0; n < 2; ++n) acc[a][b][m][n] = (f32x4){0.f, 0.f, 0.f, 0.f};
    bf16x8 At[4][2], B0[2][2], B1[2][2];
    const char* cA = (const char*)g.A + (size_t)cur.pm * tstepA; const char* cB = (const char*)g.Bt + (size_t)cur.pn * tstepB;
    S.a_ready(cur);
    if constexpr (SP2) {
        PG8_STAGE(PG8_SB(0, 0), cB, voffB); PG8_STAGE(PG8_SB(0, 1), cB + hstepB, voffB); PG8_STAGE(PG8_SA(0, 0), cA, voffA); PG8_STAGE(PG8_SA(0, 1), cA + hstepA, voffA);
        if (wr == 1) PG8_BAR;
        PG8_WAIT_V(2); PG8_BAR;
        PG8_STAGE(PG8_SB(1, 0), cB + kstep, voffB); PG8_STAGE(PG8_SA(1, 0), cA + kstep, voffA); PG8_STAGE(PG8_SB(1, 1), cB + hstepB + kstep, voffB);
        PG8_WAIT_V(6); PG8_BAR;
    } else {
        PG8_STAGE(PG8_SB(0, 0), cB, voffB); PG8_STAGE(PG8_SA(0, 0), cA, voffA); PG8_STAGE(PG8_SB(0, 1), cB + hstepB, voffB); PG8_STAGE(PG8_SA(0, 1), cA + hstepA, voffA);
        if (wr == 1) PG8_BAR;
        PG8_WAIT_V(4); PG8_BAR;
        PG8_STAGE(PG8_SB(1, 0), cB + kstep, voffB); PG8_STAGE(PG8_SA(1, 0), cA + kstep, voffA); PG8_STAGE(PG8_SB(1, 1), cB + hstepB + kstep, voffB);
        PG8_WAIT_V(6); PG8_BAR;
    }
    for (;;) {
        const bool has_next = S.next(ui + 1, nxt);
        const char* nA = has_next ? (const char*)g.A + (size_t)nxt.pm * tstepA : cA; const char* nB = has_next ? (const char*)g.Bt + (size_t)nxt.pn * tstepB : cB;
        for (int t = 0; t < nt; t += 2) {
            const bool last = (t == nt - 2);
            const char* a1 = cA + (size_t)(t + 1) * kstep;
            const char* a2 = last ? nA : cA + (size_t)(t + 2) * kstep; const char* b2 = last ? nB : cB + (size_t)(t + 2) * kstep;
            const char* a3 = a2 + kstep; const char* b3 = b2 + kstep;
            if (last && has_next) S.a_ready(nxt);
            if constexpr (Epi::HAS_MID) { if (t == nt / 2) E.mid(acc, cur, wr, wc, fr, fq); }
            if constexpr (SP2) {
            PG8_LDB(B0, 0, 0); PG8_LDB(B1, 0, 1); PG8_SCHED; PG8_LDA(At, 0, 0); PG8_STAGE(PG8_SA(1, 1), a1 + hstepA, voffA);
            PG8_WAIT_V(8); PG8_WAIT_L(0); PG8_BAR; PG8_MMA(0, 0, At, B0); PG8_MMA(0, 1, At, B1); PG8_BAR; PG8_SCHED;
            PG8_LDA(At, 0, 1); PG8_STAGE(PG8_SB(0, 0), b2, voffB); PG8_STAGE(PG8_SB(0, 1), b2 + hstepB, voffB); PG8_STAGE(PG8_SA(0, 0), a2, voffA);
            PG8_WAIT_V(8); PG8_WAIT_L(0); PG8_BAR; PG8_MMA(1, 0, At, B0); PG8_MMA(1, 1, At, B1); PG8_BAR; PG8_SCHED;
            PG8_LDB(B0, 1, 0); PG8_LDB(B1, 1, 1); PG8_SCHED; PG8_LDA(At, 1, 0); PG8_STAGE(PG8_SA(0, 1), a2 + hstepA, voffA);
            PG8_WAIT_V(8); PG8_WAIT_L(0); PG8_BAR; PG8_MMA(0, 0, At, B0); PG8_MMA(0, 1, At, B1); PG8_BAR; PG8_SCHED;
            PG8_LDA(At, 1, 1); PG8_STAGE(PG8_SB(1, 0), b3, voffB); PG8_STAGE(PG8_SB(1, 1), b3 + hstepB, voffB); PG8_STAGE(PG8_SA(1, 0), a3, voffA);
            PG8_WAIT_V(8); PG8_WAIT_L(0); PG8_BAR; PG8_MMA(1, 0, At, B0); PG8_MMA(1, 1, At, B1); PG8_BAR; PG8_SCHED;
            } else {
            PG8_LDB(B0, 0, 0); PG8_SCHED; PG8_LDA(At, 0, 0); PG8_STAGE(PG8_SA(1, 1), a1 + hstepA, voffA);
            PG8_WAIT_L(8); PG8_BAR; PG8_WAIT_L(0); PG8_MMA(0, 0, At, B0); PG8_BAR; PG8_SCHED;
            PG8_LDB(B1, 0, 1); PG8_STAGE(PG8_SB(0, 0), b2, voffB);
            PG8_BAR; PG8_WAIT_L(0); PG8_MMA(0, 1, At, B1); PG8_BAR;
            PG8_LDA(At, 0, 1); PG8_STAGE(PG8_SA(0, 0), a2, voffA);
            PG8_BAR; PG8_WAIT_L(0); PG8_MMA(1, 0, At, B0); PG8_BAR; PG8_SCHED;
            PG8_STAGE(PG8_SB(0, 1), b2 + hstepB, voffB);
            PG8_WAIT_V(6); PG8_BAR; PG8_MMA(1, 1, At, B1); PG8_BAR;
            PG8_LDB(B0, 1, 0); PG8_SCHED; PG8_LDA(At, 1, 0); PG8_STAGE(PG8_SA(0, 1), a2 + hstepA, voffA);
            PG8_WAIT_L(8); PG8_BAR; PG8_WAIT_L(0); PG8_MMA(0, 0, At, B0); PG8_BAR; PG8_SCHED;
            PG8_LDB(B1, 1, 1); PG8_STAGE(PG8_SB(1, 0), b3, voffB);
            PG8_BAR; PG8_WAIT_L(0); PG8_MMA(0, 1, At, B1); PG8_BAR;
            PG8_LDA(At, 1, 1); PG8_STAGE(PG8_SA(1, 0), a3, voffA);
            PG8_BAR; PG8_WAIT_L(0); PG8_MMA(1, 0, At, B0); PG8_BAR; PG8_SCHED;
            PG8_STAGE(PG8_SB(1, 1), b3 + hstepB, voffB);
            PG8_WAIT_V(6); PG8_BAR; PG8_MMA(1, 1, At, B1); PG8_BAR;
            }
        }
        if constexpr (ALIGN_EPI) { if (wr == 0) PG8_BAR; }
        if constexpr (!Epi::AFTER_DRAIN) { E(acc, cur, wr, wc, fr, fq); S.done(cur); }
        if (!has_next) break;
#pragma unroll
        for (int a = 0; a < 2; ++a)
#pragma unroll
            for (int b = 0; b < 2; ++b)
#pragma unroll
                for (int m = 0; m < 4; ++m)
#pragma unroll
                    for (int n = 0; n < 2; ++n) acc[a][b][m][n] = (f32x4){0.f, 0.f, 0.f, 0.f};
        cur = nxt; cA = nA; cB = nB; ++ui;
        if constexpr (ALIGN_EPI) { if (wr == 1) PG8_BAR; }
    }
    PG8_WAIT_V(0);
    if constexpr (!ALIGN_EPI) { if (wr == 0) PG8_BAR; }
    PG8_BAR;
#undef PG8_SA
#undef PG8_SB
#undef PG8_STAGE
#undef PG8_LDA
#undef PG8_LDB
#undef PG8_MMA
#undef PG8_WAIT_V
#undef PG8_WAIT_L
#undef PG8_BAR
#undef PG8_SCHED
}
}

#ifndef PG8_SP2
#define PG8_SP2 true
#endif
#ifndef PG8_ALIGN
#define PG8_ALIGN true
#endif

constexpr int NWAVES = 8;
constexpr int N_LAUNCHES = MK_N_LAUNCHES;
constexpr int PER_PHASE = 12;
constexpr int DM = 1024, BATCH = 16, SEQ = 2048, M = BATCH * SEQ, CHK = 64;
constexpr int DIN = 5640, NPROJ = 5632, DFF = 2816, PLE = 256;
constexpr int C_QA = 0, C_KA = 512, C_VA = 1024, C_CONV = 1536, C_GA = 3072, C_GB = 4096, C_Z = 5120;
constexpr int NREL = 257;
constexpr float EPS = 1e-6f;

constexpr size_t MiB = 1u << 20;
constexpr size_t WS_CTL = 0, CTL_ZERO_BYTES = 128 * 1024;
constexpr size_t WS_WIN = 1 * MiB;
constexpr size_t WS_WA = 12 * MiB, WS_WB = 13 * MiB;
constexpr size_t WS_WO = 14 * MiB;
constexpr size_t WS_WGU = 16 * MiB;
constexpr size_t WS_WDN = 27 * MiB;
constexpr size_t WS_WPG = 33 * MiB;
constexpr size_t WS_WPP = 35 * MiB;
constexpr size_t WS_BD = 36 * MiB;
constexpr size_t WS_PB = 37 * MiB;
constexpr size_t WS_SSQ1 = 53 * MiB, WS_SSQ2 = 55 * MiB;
constexpr size_t WS_SSQ3 = 60 * MiB;
constexpr size_t WS_EGL = 57 * MiB;
constexpr size_t WS_PQK = 480 * MiB;
constexpr int CW_ATTQ = 2048;
constexpr int CW_P8 = 8192;
constexpr int CW_LATEQ = 3072;
constexpr int CW_PANEL = 16384;
constexpr size_t WS_RA = 64 * MiB;
constexpr size_t WS_PROJ = 128 * MiB;
constexpr size_t WS_X = 128 * MiB, WS_HFF = 256 * MiB, WS_PP = 432 * MiB;
constexpr size_t WS_END = 512 * MiB;
constexpr int CW_TMO = 0, CW_CODE = 1, CW_BAR = 4096;

constexpr int RING_OFF = 0, RING_BYTES = 147456;
constexpr int LDSCTL_OFF = RING_BYTES, MISC_OFF = LDSCTL_OFF + 320;
constexpr int LDS_BYTES = 149504;

#define GAS __attribute__((address_space(1)))
#define LAS __attribute__((address_space(3)))
typedef unsigned short bf16;
typedef unsigned v4u __attribute__((ext_vector_type(4)));
typedef float f32x4 __attribute__((ext_vector_type(4)));
typedef GAS unsigned gu32;
#define RLX_AGENT __ATOMIC_RELAXED, __HIP_MEMORY_SCOPE_AGENT
#define LDS_WAIT() asm volatile("s_waitcnt lgkmcnt(0)" ::: "memory")
#define VM_WAIT() asm volatile("s_waitcnt vmcnt(0)" ::: "memory")
__device__ __forceinline__ unsigned f2bf(float f) { unsigned u = __builtin_bit_cast(unsigned, f); return (u + 0x7fffu + ((u >> 16) & 1u)) >> 16; }
__device__ __forceinline__ unsigned pk2(float lo, float hi) { return f2bf(lo) | (f2bf(hi) << 16); }
__device__ __forceinline__ float bflo(unsigned u) { return __uint_as_float(u << 16); }
__device__ __forceinline__ float bfhi(unsigned u) { return __uint_as_float(u & 0xffff0000u); }
__device__ __forceinline__ float bf1(bf16 h) { return __uint_as_float(((unsigned)h) << 16); }
__device__ __forceinline__ void glds16(const void* gsrc, unsigned lds_dst) { unsigned keep;
    asm volatile("s_mov_b32 %0, m0\n\ts_mov_b32 m0, %2\n\ts_nop 0\n\tglobal_load_lds_dwordx4 %1, off\n\ts_mov_b32 m0, %0" : "=&s"(keep) : "v"(gsrc), "s"(lds_dst) : "memory"); }
#define LDS_ADDR(p) ((unsigned)(unsigned long)(p))

#define XB_TMO      128
#define XB_XCNT(j)  (256  + 64 * (j))
#define XB_XSUB(j)  (1280 + 64 * (j))
#define XB_XGEN(j)  (2304 + 64 * (j))
#define XB_TOP      3328
#define XB_TOPGEN   3392
#define XCD_BAR_WORDS 3456
#define XB_SPIN_CAP (1u << 18)
__device__ __forceinline__ unsigned xb_ld(unsigned* p)              { return __hip_atomic_load(p, __ATOMIC_RELAXED, __HIP_MEMORY_SCOPE_AGENT); }
__device__ __forceinline__ unsigned xb_add(unsigned* p, unsigned v) { return __hip_atomic_fetch_add(p, v, __ATOMIC_RELAXED, __HIP_MEMORY_SCOPE_AGENT); }
__device__ __forceinline__ unsigned xb_xcc_id() { return (unsigned)__builtin_amdgcn_s_getreg((3 << 11) | 20) & 0xFu; }
#define XB_SPIN(cond, bar) do { unsigned _sp = 0; while (cond) { __builtin_amdgcn_s_sleep(1); \
    if ((++_sp & 255u) == 0u) { if (xb_ld(&(bar)[XB_TMO])) break; if (_sp > XB_SPIN_CAP) { atomicAdd(&(bar)[XB_TMO], 1u); break; } } } } while (0)
struct XcdBarrier { unsigned* bar; unsigned x; volatile LAS unsigned* st; };
__device__ __forceinline__ XcdBarrier xcd_barrier_post(unsigned* bar, volatile LAS unsigned* st) {
    XcdBarrier b; b.bar = bar; b.x = xb_xcc_id(); b.st = st;
    if (threadIdx.x == 0) (void)xb_add(&bar[XB_XCNT(b.x)], 1u);
    return b;
}
__device__ __forceinline__ void xcd_barrier_complete(unsigned* bar, unsigned x, unsigned& nloc, unsigned& nx) {
    const unsigned G = gridDim.x * gridDim.y * gridDim.z;
    unsigned sum, cnt, mine, sp = 0u;
    for (;;) {
        sum = 0u; cnt = 0u; mine = 0u;
#pragma unroll
        for (unsigned j = 0; j < 16; ++j) { const unsigned c = xb_ld(&bar[XB_XCNT(j)]); sum += c; cnt += (c > 0u) ? 1u : 0u; mine = (j == x) ? c : mine; }
        if (sum == G) break;
        __builtin_amdgcn_s_sleep(1);
        if ((++sp & 255u) == 0u) { if (xb_ld(&bar[XB_TMO])) break; if (sp > XB_SPIN_CAP) { atomicAdd(&bar[XB_TMO], 1u); break; } }
    }
    nloc = mine > 0u ? mine : 1u; nx = cnt > 0u ? cnt : 1u;
}
__device__ __forceinline__ void xcd_barrier(const XcdBarrier& b) {
    asm volatile("s_waitcnt vmcnt(0)" ::: "memory");
    __syncthreads();
    if (threadIdx.x == 0) {
        unsigned* bar = b.bar;
        __builtin_amdgcn_s_waitcnt(0);
        unsigned nloc = b.st[0], nx = b.st[1];
        if (nloc == 0u) { xcd_barrier_complete(bar, b.x, nloc, nx); b.st[0] = nloc; b.st[1] = nx; }
        const unsigned old = xb_add(&bar[XB_XSUB(b.x)], 1u);
        const unsigned gen = old / nloc;
        if (old + 1u == (gen + 1u) * nloc) {
            __builtin_amdgcn_fence(__ATOMIC_RELEASE, "agent");
            asm volatile("s_waitcnt vmcnt(0)" ::: "memory");
            const unsigned og = xb_add(&bar[XB_TOP], 1u);
            const unsigned tg = og / nx;
            if (og + 1u == (tg + 1u) * nx) xb_add(&bar[XB_TOPGEN], 1u);
            else XB_SPIN(xb_ld(&bar[XB_TOPGEN]) == tg, bar);
            __builtin_amdgcn_fence(__ATOMIC_ACQUIRE, "agent");
            xb_add(&bar[XB_XGEN(b.x)], 1u);
            asm volatile("s_waitcnt vmcnt(0)" ::: "memory");
        } else {
            XB_SPIN(xb_ld(&bar[XB_XGEN(b.x)]) == gen, bar);
            __builtin_amdgcn_fence(__ATOMIC_ACQUIRE, "agent");
            asm volatile("s_waitcnt vmcnt(0)" ::: "memory");
        }
    }
    __syncthreads();
}

struct Frame {
    LAS unsigned char* lds;
    volatile LAS unsigned* MISC;
    gu32* ctl;
    int tid, lane, wave;
    int vcu, G;
    const float *x, *p, *g_mix, *w_in, *conv_w, *a_log, *dt_bias, *rel_bias, *w_onorm, *w_a, *w_b, *w_out, *g_ffn, *w_gu, *w_dn, *g_ple, *w_pg, *w_pp, *g_final;
    float* out;
    bf16 *Win_t, *Wa_t, *Wb_t, *Wo_t, *Wgu_t, *Wdn_t, *Wpg_t, *Wpp_t;
    float *BD, *SSQ1, *SSQ2, *EGL, *X;
    bf16 *PB, *RA, *PROJ, *HFF, *PP, *TA, *MERGED, *DU, *DNWK, *DQG, *DKDT, *DPQK;
};

template <int CTRL> __device__ __forceinline__ float dppf(float v) { return __builtin_bit_cast(float, __builtin_amdgcn_update_dpp(0, __builtin_bit_cast(int, v), CTRL, 0xf, 0xf, true)); }
__device__ __forceinline__ float row16_sum(float v) {
    v += dppf<0xB1>(v); v += dppf<0x4E>(v); v += dppf<0x141>(v); v += dppf<0x140>(v); return v;
}
__device__ __forceinline__ float half_swap_sum(float v) {
    const auto r = __builtin_amdgcn_permlane32_swap(__float_as_uint(v), __float_as_uint(v), false, false); return __uint_as_float(r[0]) + __uint_as_float(r[1]);
}
__device__ __forceinline__ float wave_sum(float v) {
    v = row16_sum(v);
    { const auto r = __builtin_amdgcn_permlane16_swap(__float_as_uint(v), __float_as_uint(v), false, false); v = __uint_as_float(r[0]) + __uint_as_float(r[1]); }
    return half_swap_sum(v);
}
__device__ __forceinline__ float sigm_(float x) { return __builtin_amdgcn_rcpf(1.0f + __builtin_amdgcn_exp2f(-1.4426950408889634f * x)); }

__device__ __forceinline__ void p0_transpose_blk(const float* W, int K, int Nsrc, bf16* WT, const float* g, int k0, int ns0, int nd0, LAS float* scr, int lane, int ldw = 0) {
    if (ldw == 0) ldw = K;
    const int n4 = (lane & 7) * 4, kr = lane >> 3;
    f32x4 w[8];
#pragma unroll
    for (int i = 0; i < 8; ++i) w[i] = __builtin_nontemporal_load((const f32x4*)(W + (size_t)(k0 + kr + 8 * i) * Nsrc + ns0 + n4));
#pragma unroll
    for (int i = 0; i < 8; ++i) { const int kk = kr + 8 * i; const float gs = g ? g[k0 + kk] : 1.f; LAS float* d = scr + kk * 33 + n4;
        d[0] = w[i][0] * gs; d[1] = w[i][1] * gs; d[2] = w[i][2] * gs; d[3] = w[i][3] * gs; }
    LDS_WAIT(); asm volatile("" ::: "memory");
    const int c = lane & 7;
#pragma unroll
    for (int j = 0; j < 4; ++j) { const int n = (lane >> 3) + 8 * j; const LAS float* s = scr + (8 * c) * 33 + n;
        v4u o; o.x = pk2(s[0 * 33], s[1 * 33]); o.y = pk2(s[2 * 33], s[3 * 33]); o.z = pk2(s[4 * 33], s[5 * 33]); o.w = pk2(s[6 * 33], s[7 * 33]);
        *(GAS v4u*)(WT + (size_t)(nd0 + n) * ldw + k0 + 8 * c) = o; }
    LDS_WAIT(); asm volatile("" ::: "memory");
}

template <int WHICH> __device__ __forceinline__ void late_weights_q(Frame& F) {
    LAS float* scr = (LAS float*)(F.lds + RING_OFF + F.wave * 16384);
    const int lane = lane_id();
    constexpr int I_GU = 16 * 176, I_DN = 44 * 32, I_PG = 16 * 32, I_PP = 4 * 32, I_PB = 2048;
    constexpr int NITEMS = WHICH == 0 ? I_GU : WHICH == 1 ? I_DN : I_PG + I_PP + I_PB;
    for (;;) {
        if (F.wave == 0 && lane == 0) F.MISC[18] = __hip_atomic_fetch_add((unsigned*)(F.ctl + CW_LATEQ + 64 * WHICH), 1u, RLX_AGENT);
        asm volatile("s_waitcnt lgkmcnt(0)" ::: "memory"); __builtin_amdgcn_s_barrier(); asm volatile("" ::: "memory");
        const unsigned tk = F.MISC[18];
        asm volatile("s_waitcnt lgkmcnt(0)" ::: "memory"); __builtin_amdgcn_s_barrier(); asm volatile("" ::: "memory");
        if ((int)tk * NWAVES >= NITEMS) break;
        int r = (int)tk * NWAVES + F.wave;
        if (r >= NITEMS) continue;
        if (WHICH == 0) { const int kb = r / 176, db = r % 176; const int tile = db >> 3, wi = db & 7; const int ns0 = wi < 4 ? 128 * tile + 32 * wi : DFF + 128 * tile + 32 * (wi - 4);
            p0_transpose_blk(F.w_gu, 1024, 2 * DFF, F.Wgu_t, F.g_ffn, 64 * kb, ns0, 32 * db, scr, lane); }
        else if (WHICH == 1) { const int kb = r / 32, db = r % 32; p0_transpose_blk(F.w_dn, DFF, 1024, F.Wdn_t, nullptr, 64 * kb, 32 * db, 32 * db, scr, lane); }
        else {
            if (r < I_PG) { const int kb = r / 32, db = r % 32; p0_transpose_blk(F.w_pg, 1024, 1024, F.Wpg_t, F.g_ple, 64 * kb, 32 * db, 32 * db, scr, lane); continue; } r -= I_PG;
            if (r < I_PP) { const int kb = r / 32, db = r % 32; p0_transpose_blk(F.w_pp, PLE, 1024, F.Wpp_t, nullptr, 64 * kb, 32 * db, 32 * db, scr, lane); continue; } r -= I_PP;
#pragma unroll
            for (int q = 0; q < 8; ++q) { const size_t i = (size_t)r * 512 + q * 64 + lane; const f32x4 a = __builtin_nontemporal_load((const f32x4*)F.p + 2 * i), b = __builtin_nontemporal_load((const f32x4*)F.p + 2 * i + 1);
                v4u o; o.x = pk2(a[0], a[1]); o.y = pk2(a[2], a[3]); o.z = pk2(b[0], b[1]); o.w = pk2(b[2], b[3]); *((v4u*)F.PB + i) = o; }
        }
    }
}

__device__ __forceinline__ void p0_prologue(Frame& F) {
    LAS float* scr = (LAS float*)(F.lds + RING_OFF + F.wave * 16384);
    const int gw = F.vcu * NWAVES + F.wave, NGW = F.G * NWAVES;
    constexpr int I_IN = 16 * 176, I_A = 8 * 32, I_O = 16 * 32;
    constexpr int NITEMS = I_IN + 2 * I_A + I_O;
    for (int it = gw; it < NITEMS; it += NGW) {
        int r = it;
        if (r < I_IN) { const int kb = r / 176, db = r % 176; const int ns0 = db < 96 ? 32 * db : (db < 160 ? 32 * (db - 96) + 3592 : 32 * (db - 160) + 3072); p0_transpose_blk(F.w_in, 1024, DIN, F.Win_t, nullptr, 64 * kb, ns0, 32 * db, scr, F.lane); continue; } r -= I_IN;
        if (r < I_A) { const int kb = r / 32, db = r % 32; p0_transpose_blk(F.w_a, 512, 1024, F.Wa_t, nullptr, 64 * kb, 32 * db, 32 * db, scr, F.lane, 1024); continue; } r -= I_A;
        if (r < I_A) { const int kb = r / 32, db = r % 32; p0_transpose_blk(F.w_b, 512, 1024, F.Wa_t + 512, nullptr, 64 * kb, 32 * db, 32 * db, scr, F.lane, 1024); continue; } r -= I_A;
        { const int kb = r / 32, db = r % 32; p0_transpose_blk(F.w_out, 1024, 1024, F.Wo_t, nullptr, 64 * kb, 32 * db, 32 * db, scr, F.lane); }
    }
    {
        __syncthreads();
        LAS float* wl = (LAS float*)(F.lds + RING_OFF);
        for (int k = F.tid; k < DM; k += NWAVES * 64) { const float* wr_ = F.w_in + (size_t)k * DIN + 3584; const f32x4 a = *(const f32x4*)wr_, b = *(const f32x4*)(wr_ + 4);
            wl[0 * DM + k] = a[0]; wl[1 * DM + k] = a[1]; wl[2 * DM + k] = a[2]; wl[3 * DM + k] = a[3]; wl[4 * DM + k] = b[0]; wl[5 * DM + k] = b[1]; wl[6 * DM + k] = b[2]; wl[7 * DM + k] = b[3]; }
        __syncthreads();
        f32x4 gm[4], wbd[8][4];
#pragma unroll
        for (int j = 0; j < 4; ++j) { gm[j] = *((const GAS f32x4*)F.g_mix + F.lane + 64 * j);
#pragma unroll
            for (int q = 0; q < 8; ++q) wbd[q][j] = *((const LAS f32x4*)(wl + q * DM) + F.lane + 64 * j); }
        f32x4 v[4], vn[4];
        { const GAS f32x4* xr = (const GAS f32x4*)(F.x + (size_t)gw * DM) + F.lane;
#pragma unroll
            for (int j = 0; j < 4; ++j) vn[j] = __builtin_nontemporal_load(xr + 64 * j); }
        for (int m = gw; m < M; m += NGW) {
#pragma unroll
            for (int j = 0; j < 4; ++j) v[j] = vn[j];
            if (m + NGW < M) { const GAS f32x4* xr = (const GAS f32x4*)(F.x + (size_t)(m + NGW) * DM) + F.lane;
#pragma unroll
                for (int j = 0; j < 4; ++j) vn[j] = __builtin_nontemporal_load(xr + 64 * j); }
            float s = 0.f;
#pragma unroll
            for (int j = 0; j < 4; ++j) s += (v[j].x * v[j].x + v[j].y * v[j].y) + (v[j].z * v[j].z + v[j].w * v[j].w);
            const float rstd = __builtin_amdgcn_rsqf(wave_sum(s) * (1.f / DM) + EPS);
            GAS unsigned long long* o8 = (GAS unsigned long long*)(F.RA + (size_t)m * DM) + F.lane;
            float d[8] = {0.f, 0.f, 0.f, 0.f, 0.f, 0.f, 0.f, 0.f};
#pragma unroll
            for (int j = 0; j < 4; ++j) { v[j] = v[j] * rstd * gm[j];
                o8[64 * j] = (unsigned long long)pk2(v[j].x, v[j].y) | ((unsigned long long)pk2(v[j].z, v[j].w) << 32);
#pragma unroll
                for (int q = 0; q < 8; ++q) d[q] += (v[j].x * wbd[q][j][0] + v[j].y * wbd[q][j][1]) + (v[j].z * wbd[q][j][2] + v[j].w * wbd[q][j][3]); }
#pragma unroll
            for (int q = 0; q < 8; ++q) d[q] = wave_sum(d[q]);
            if (F.lane == 0) { *(f32x4*)(F.BD + (size_t)m * 8) = (f32x4){d[0], d[1], d[2], d[3]}; *(f32x4*)(F.BD + (size_t)m * 8 + 4) = (f32x4){d[4], d[5], d[6], d[7]}; }
        }
    }
}

namespace att {
typedef short bf16x8 __attribute__((ext_vector_type(8)));
typedef short s16x4 __attribute__((ext_vector_type(4)));
typedef short v4i16_t __attribute__((ext_vector_type(4)));
typedef float f32x16 __attribute__((ext_vector_type(16)));
typedef float f32x2_t __attribute__((ext_vector_type(2)));
typedef __bf16 bf16x2_t __attribute__((ext_vector_type(2)));
constexpr int SLOTB = 8192, NSLOT = 5, LDS_K = 0, LDS_V = 40960, LDS_BIAS = 81920, LDS_WS = 83968, LDS_OST = 86016;
constexpr float LOG2E = 1.4426950408889634f, C2 = 0.125f * 1.4426950408889634f;
__device__ __forceinline__ int crow(int r, int hi) { return (r & 3) + 8 * (r >> 2) + 4 * hi; }
__device__ __forceinline__ unsigned cvtpk(float lo, float hi) { f32x2_t v = {lo, hi}; bf16x2_t b = __builtin_convertvector(v, bf16x2_t); return __builtin_bit_cast(unsigned, b); }
__device__ __forceinline__ s16x4 vtr(const LAS unsigned char* p) { return __builtin_bit_cast(s16x4, __builtin_amdgcn_ds_read_tr16_b64_v4i16((LAS v4i16_t*)p)); }
__device__ __forceinline__ bf16x8 frag_of(const f32x16& x, int s) { v4u w; w.x = cvtpk(x[8 * s], x[8 * s + 1]); w.y = cvtpk(x[8 * s + 2], x[8 * s + 3]); w.z = cvtpk(x[8 * s + 4], x[8 * s + 5]); w.w = cvtpk(x[8 * s + 6], x[8 * s + 7]); return __builtin_bit_cast(bf16x8, w); }
#define MFMA32(a, b, c) __builtin_amdgcn_mfma_f32_32x32x16_bf16((a), (b), (c), 0, 0, 0)
}

__device__ __forceinline__ void attn_unit(Frame& F, int b, int h, int qg) {
    using namespace att;
    const int tid = F.tid, lane = F.lane, r32 = lane & 31, hi = lane >> 5, wid = F.wave;
    LAS unsigned char* shm = F.lds;
    const int c0 = 4 * qg, cq = c0 + (wid >> 1), qi = (wid & 1) * 32 + r32;
    const size_t rowbase = (size_t)b * SEQ;
    LAS float* biasT = (LAS float*)(shm + LDS_BIAS);
    for (int i = tid; i < NREL; i += NWAVES * 64) biasT[i] = F.rel_bias[h * NREL + i] * LOG2E;
    const bf16* Qrow = F.PROJ + (rowbase + cq * 64 + qi) * NPROJ + C_QA + h * 64;
    bf16x8 qr[4];
#pragma unroll
    for (int d0 = 0; d0 < 4; ++d0) { const v4u w = *(const v4u*)(Qrow + d0 * 16 + hi * 8); v4u o;
        o.x = cvtpk(bflo(w.x) * C2, bfhi(w.x) * C2); o.y = cvtpk(bflo(w.y) * C2, bfhi(w.y) * C2); o.z = cvtpk(bflo(w.z) * C2, bfhi(w.z) * C2); o.w = cvtpk(bflo(w.w) * C2, bfhi(w.w) * C2);
        qr[d0] = __builtin_bit_cast(bf16x8, o); }
    const float bc = F.rel_bias[h * NREL + 256] * LOG2E;
    const int kc_lo = c0 >= 8 ? c0 - 8 : 0, kc_hi = c0 + 3;
    const bf16* ksrc = F.PROJ + (rowbase + 16 * (wid & 3) + (lane >> 2)) * NPROJ + C_KA + h * 64 + (wid >> 2) * 32 + (lane & 3) * 8;
    const bf16* vsrc = F.PROJ + (rowbase + 16 * (wid & 3) + (lane >> 2)) * NPROJ + C_VA + h * 64 + (wid >> 2) * 32 + (lane & 3) * 8;
#define ATT_DMA(kc, slot) do { \
        glds16(ksrc + (size_t)(kc) * 64 * NPROJ, (unsigned)__builtin_amdgcn_readfirstlane(LDS_ADDR(shm + LDS_K + (slot) * SLOTB + wid * 1024))); \
        glds16(vsrc + (size_t)(kc) * 64 * NPROJ, (unsigned)__builtin_amdgcn_readfirstlane(LDS_ADDR(shm + LDS_V + (slot) * SLOTB + wid * 1024))); } while (0)
    float mhat = 0.f; bool first = true;
    f32x16 o0 = {}, o1 = {}, lt = {}, cbm;
#pragma unroll
    for (int r = 0; r < 16; ++r) cbm[r] = bc;
    const bf16x8 ones = {0x3F80, 0x3F80, 0x3F80, 0x3F80, 0x3F80, 0x3F80, 0x3F80, 0x3F80};
    LAS float* wsf = (LAS float*)(shm + LDS_WS) + wid * 64;
    asm volatile("" : "+v"(qr[0]), "+v"(qr[1]), "+v"(qr[2]), "+v"(qr[3]), "+v"(cbm));
    LDS_WAIT();
    ATT_DMA(kc_lo, 0); ATT_DMA(kc_lo + 1, 1); ATT_DMA(kc_lo + 2, 2);
    const bool late = wid >= 4;
    bf16x8 pa0, pa1, pa2, pa3; bool pend = false; int pslot = 0;
    const int vlane = ((lane >> 4) & 1) * 32 + (lane & 3) * 8 + (4 * hi + ((lane & 15) >> 2)) * 64;
#define ATT_VF(d0, ks) ({ const s16x4 lo_ = vtr(vp + (d0) * 4096 + (ks) * 1024), hi_ = vtr(vp + (d0) * 4096 + (ks) * 1024 + 512); (bf16x8){lo_[0], lo_[1], lo_[2], lo_[3], hi_[0], hi_[1], hi_[2], hi_[3]}; })
#define ATT_PV(vslot) do { const LAS unsigned char* vp = shm + LDS_V + (vslot) * SLOTB + vlane; \
        o0 = MFMA32(pa0, ATT_VF(0, 0), o0); o0 = MFMA32(pa1, ATT_VF(0, 1), o0); o0 = MFMA32(pa2, ATT_VF(0, 2), o0); o0 = MFMA32(pa3, ATT_VF(0, 3), o0); \
        o1 = MFMA32(pa0, ATT_VF(1, 0), o1); o1 = MFMA32(pa1, ATT_VF(1, 1), o1); o1 = MFMA32(pa2, ATT_VF(1, 2), o1); o1 = MFMA32(pa3, ATT_VF(1, 3), o1); \
        lt = MFMA32(pa0, ones, lt); lt = MFMA32(pa1, ones, lt); lt = MFMA32(pa2, ones, lt); lt = MFMA32(pa3, ones, lt); } while (0)
    int slot = 0;
#pragma unroll 1
    for (int kc = kc_lo; kc <= kc_hi; ++kc) {
        if (kc + 2 <= kc_hi) asm volatile("s_waitcnt vmcnt(4)" ::: "memory"); else if (kc + 1 <= kc_hi) asm volatile("s_waitcnt vmcnt(2)" ::: "memory"); else asm volatile("s_waitcnt vmcnt(0)" ::: "memory");
        __builtin_amdgcn_s_barrier(); asm volatile("" ::: "memory");
        if (kc + 3 <= kc_hi) ATT_DMA(kc + 3, (slot + 3) % NSLOT);
        if (late && pend) { ATT_PV(pslot); pend = false; }
        if (kc >= cq - 8 && kc <= cq) {
            const LAS unsigned char* kb = shm + LDS_K + slot * SLOTB + (r32 >> 4) * 1024 + (r32 & 15) * 64 + hi * 16;
            const int dist = cq - kc;
            f32x16 p0, p1;
            if (dist >= 3) { p0 = cbm; p1 = cbm; }
            else {
#pragma unroll
                for (int r = 0; r < 16; ++r) { const int kk = crow(r, hi); int r0 = 64 * dist + qi - kk, r1 = r0 - 32;
                    r0 = r0 > 128 ? 128 : r0; r1 = r1 > 128 ? 128 : r1;
                    p0[r] = biasT[r0 + 128] - mhat; p1[r] = biasT[r1 + 128] - mhat; } }
#pragma unroll
            for (int d0 = 0; d0 < 4; ++d0) {
                const bf16x8 b0 = *(const LAS bf16x8*)(kb + (d0 >> 1) * 4096 + (d0 & 1) * 32), b1 = *(const LAS bf16x8*)(kb + (d0 >> 1) * 4096 + (d0 & 1) * 32 + 2048);
                p0 = MFMA32(b0, qr[d0], p0); p1 = MFMA32(b1, qr[d0], p1); }
            float rm = fmaxf(fmaxf(p0[0], p1[0]), fmaxf(p0[1], p1[1]));
#pragma unroll
            for (int r = 2; r < 16; r += 2) rm = fmaxf(rm, fmaxf(fmaxf(p0[r], p1[r]), fmaxf(p0[r + 1], p1[r + 1])));
            { const auto rr_ = __builtin_amdgcn_permlane32_swap(__float_as_uint(rm), __float_as_uint(rm), false, false); rm = fmaxf(__uint_as_float(rr_[0]), __uint_as_float(rr_[1])); }
            if (first || __any(rm > 6.0f)) {
                const float dl = first ? rm : fmaxf(rm, 0.f);
                mhat += dl;
#pragma unroll
                for (int r = 0; r < 16; ++r) { p0[r] -= dl; p1[r] -= dl; cbm[r] = bc - mhat; }
                if (!first) {
                    if (hi == 0) wsf[r32] = __builtin_amdgcn_exp2f(-dl);
                    LDS_WAIT(); asm volatile("" ::: "memory");
#pragma unroll
                    for (int r = 0; r < 16; ++r) { const float a = wsf[crow(r, hi)]; o0[r] *= a; o1[r] *= a; lt[r] *= a; }
                    LDS_WAIT(); asm volatile("" ::: "memory");
                }
                first = false;
            }
#pragma unroll
            for (int r = 0; r < 16; ++r) { p0[r] = __builtin_amdgcn_exp2f(p0[r]); p1[r] = __builtin_amdgcn_exp2f(p1[r]); }
            pa0 = frag_of(p0, 0); pa1 = frag_of(p0, 1); pa2 = frag_of(p1, 0); pa3 = frag_of(p1, 1);
            if (late) { pend = true; pslot = slot; } else { ATT_PV(slot); }
            LDS_WAIT(); asm volatile("" ::: "memory");
        }
        slot = (slot + 1 == NSLOT) ? 0 : slot + 1;
    }
    if (late && pend) { ATT_PV(pslot); LDS_WAIT(); asm volatile("" ::: "memory"); }
    {
        LAS bf16* stg = (LAS bf16*)(shm + LDS_OST) + wid * 2048;
#pragma unroll
        for (int r = 0; r < 16; ++r) { const int orow = crow(r, hi); const float rl = __builtin_amdgcn_rcpf(lt[r]);
            stg[orow * 64 + r32] = (bf16)f2bf(o0[r] * rl); stg[orow * 64 + 32 + r32] = (bf16)f2bf(o1[r] * rl); }
        LDS_WAIT(); asm volatile("" ::: "memory");
        bf16* Ow = F.RA + (rowbase + cq * 64 + (wid & 1) * 32) * DM + h * 64;
#pragma unroll
        for (int i = 0; i < 4; ++i) { const int row = i * 8 + (lane >> 3), ch = lane & 7; const v4u v = *(const LAS v4u*)(stg + row * 64 + ch * 8); *(v4u*)(Ow + (size_t)row * DM + ch * 8) = v; }
    }
    LDS_WAIT(); __builtin_amdgcn_s_barrier(); asm volatile("" ::: "memory");
#undef ATT_DMA
#undef ATT_VF
#undef ATT_PV
}

namespace dn {
using namespace att;
constexpr int IT_K = 0, IT_V = 16384, IT_Q = 32768, IT_GC = 49152, IT_BT = 49152 + 256, IT_BYTES = 51200;
__device__ __forceinline__ int img_off(int l, int f) { return (f >> 5) * 4096 + (l >> 4) * 1024 + (l & 15) * 64 + (f & 31) * 2; }
struct Fr2 { bf16x8 a, b; };
__device__ __forceinline__ Fr2 frs(const f32x16& x) { Fr2 f; f.a = frag_of(x, 0); f.b = frag_of(x, 1); return f; }
__device__ __forceinline__ f32x16 mm(const Fr2& A, const Fr2& B, f32x16 C) { C = MFMA32(A.a, B.a, C); return MFMA32(A.b, B.b, C); }
__device__ __forceinline__ bf16x8 trfrag(const LAS unsigned char* p) { const s16x4 lo_ = vtr(p), hi_ = vtr(p + 512); return (bf16x8){lo_[0], lo_[1], lo_[2], lo_[3], hi_[0], hi_[1], hi_[2], hi_[3]}; }
__device__ __forceinline__ v4u pack8r(const f32x16& x, int s, float sc) { v4u w; w.x = cvtpk(x[8 * s] * sc, x[8 * s + 1] * sc); w.y = cvtpk(x[8 * s + 2] * sc, x[8 * s + 3] * sc); w.z = cvtpk(x[8 * s + 4] * sc, x[8 * s + 5] * sc); w.w = cvtpk(x[8 * s + 6] * sc, x[8 * s + 7] * sc); return w; }
}

__device__ __forceinline__ void dn_prep(Frame& F) {
    using namespace dn;
    const int tid = F.tid, lane = F.lane, r32 = lane & 31, hi = lane >> 5, wid = F.wave, j = wid >> 2, w4 = wid & 3, t256 = tid & 255;
    LAS unsigned char* base = F.lds + j * IT_BYTES;
    LAS float* GC = (LAS float*)(base + IT_GC); LAS float* BT = (LAS float*)(base + IT_BT);
    const LAS unsigned char* Kimg = base + IT_K; const LAS unsigned char* Vimg = base + IT_V; const LAS unsigned char* Qimg = base + IT_Q;
    const int lanepart = ((lane >> 4) & 1) * 32 + (lane & 3) * 8 + (4 * hi + ((lane & 15) >> 2)) * 64;
    LAS float* cwl = (LAS float*)(F.lds + 2 * IT_BYTES);
    for (int i = tid; i < 4 * 1536 / 4; i += NWAVES * 64) ((LAS f32x4*)cwl)[i] = ((const f32x4*)F.conv_w)[i];
#pragma unroll 1
    for (int st = 0; st < 9; ++st) {
        asm volatile("s_waitcnt lgkmcnt(0)" ::: "memory"); __builtin_amdgcn_s_barrier(); asm volatile("" ::: "memory");
        const int ph = st - j; if (ph < 0 || ph >= 8) continue;
        const int iter = ph >> 1; const bool conv_stage = (ph & 1) == 0;
        const int it = (iter * 256 + (F.vcu & 255)) * 2 + j; const int bh = it >> 5, c = it & 31, b = bh >> 2, h = bh & 3; const size_t m0 = (size_t)b * SEQ + (size_t)c * CHK;
        if (conv_stage) {

        {
            const int g = t256 >> 4, c8 = t256 & 15;
            v4u xv[3][7];
#pragma unroll
            for (int part = 0; part < 3; ++part)
#pragma unroll
                for (int k = 0; k < 7; ++k) { const int row = 4 * g - 3 + k;
                    if (c * CHK + row >= 0) xv[part][k] = __builtin_nontemporal_load((const v4u*)(F.PROJ + (size_t)((long)m0 + row) * NPROJ + C_CONV + part * 512 + h * 128 + c8 * 8)); else xv[part][k] = (v4u){0u, 0u, 0u, 0u}; }
#pragma unroll
            for (int part = 0; part < 3; ++part) {
                f32x4 w0[4], w1[4];
#pragma unroll
                for (int i = 0; i < 4; ++i) { const LAS f32x4* wp = (const LAS f32x4*)(cwl + i * 1536 + part * 512 + h * 128 + c8 * 8); w0[i] = wp[0]; w1[i] = wp[1]; }
#pragma unroll
                for (int rr = 0; rr < 4; ++rr) {
                    float acc[8] = {0.f, 0.f, 0.f, 0.f, 0.f, 0.f, 0.f, 0.f};
#pragma unroll
                    for (int i = 0; i < 4; ++i) { const v4u xw = xv[part][rr + i];
                        acc[0] += bflo(xw.x) * w0[i][0]; acc[1] += bfhi(xw.x) * w0[i][1]; acc[2] += bflo(xw.y) * w0[i][2]; acc[3] += bfhi(xw.y) * w0[i][3];
                        acc[4] += bflo(xw.z) * w1[i][0]; acc[5] += bfhi(xw.z) * w1[i][1]; acc[6] += bflo(xw.w) * w1[i][2]; acc[7] += bfhi(xw.w) * w1[i][3]; }
                    float ss = 0.f;
#pragma unroll
                    for (int e = 0; e < 8; ++e) { acc[e] = acc[e] * sigm_(acc[e]); ss += acc[e] * acc[e]; }
                    if (part < 2) { ss = row16_sum(ss);
                        float rn = __builtin_amdgcn_rsqf(ss + EPS); if (part == 0) rn *= 0.08838834764831845f;
#pragma unroll
                        for (int e = 0; e < 8; ++e) acc[e] *= rn; }
                    v4u o; o.x = cvtpk(acc[0], acc[1]); o.y = cvtpk(acc[2], acc[3]); o.z = cvtpk(acc[4], acc[5]); o.w = cvtpk(acc[6], acc[7]);
                    *(LAS v4u*)(base + (part == 0 ? IT_Q : part == 1 ? IT_K : IT_V) + img_off(4 * g + rr, c8 * 8)) = o;
                }
            }
        }
        if (w4 == 0) {
            const size_t m = m0 + lane; const float br = F.BD[m * 8 + h], dr = F.BD[m * 8 + 4 + h] + F.dt_bias[h];
            const float sp = dr > 20.f ? dr : log1pf(expf(dr));
            float cs = -expf(F.a_log[h]) * sp;
#pragma unroll
            for (int o = 1; o < 64; o <<= 1) { const float t = __shfl_up(cs, o); if (lane >= o) cs += t; }
            GC[lane] = cs; BT[lane] = sigm_(br);
            if (lane == 63) F.EGL[it] = expf(cs);
        }
        } else {
        f32x16 kk00 = {}, kk11 = {}, kk10 = {};
#pragma unroll
        for (int s = 0; s < 8; ++s) { const bf16x8 ka = *(const LAS bf16x8*)(Kimg + img_off(r32, 16 * s + 8 * hi)), kb = *(const LAS bf16x8*)(Kimg + img_off(32 + r32, 16 * s + 8 * hi));
            kk00 = MFMA32(ka, ka, kk00); kk11 = MFMA32(kb, kb, kk11); kk10 = MFMA32(kb, ka, kk10); }
        const float gcC0 = GC[r32], gcC1 = GC[32 + r32], bC0 = BT[r32], bC1 = BT[32 + r32];
        f32x16 T11, T11t, T22t, T21t;
        {
            f32x16 P, Pt, T, Tt;
#pragma unroll
            for (int r = 0; r < 16; ++r) { const int rho = crow(r, hi); const float gR = GC[rho], bR = BT[rho];
                const float n = (r32 < rho) ? bR * __expf(gR - gcC0) * kk00[r] : 0.f, nt = (rho < r32) ? bC0 * __expf(gcC0 - gR) * kk00[r] : 0.f;
                const float id = (rho == r32) ? 1.f : 0.f; P[r] = n; Pt[r] = nt; T[r] = id - n; Tt[r] = id - nt; }
#pragma unroll
            for (int n = 0; n < 4; ++n) { Fr2 fP = frs(P), fPt = frs(Pt); const f32x16 z = {};
                P = mm(fPt, fP, z); Pt = mm(fP, fPt, z); fP = frs(P); fPt = frs(Pt);
                const Fr2 fT = frs(T), fTt = frs(Tt); T = mm(fPt, fT, T); Tt = mm(fP, fTt, Tt); }
            T11 = T; T11t = Tt;
        }
        {
            f32x16 P, Pt, Tt;
#pragma unroll
            for (int r = 0; r < 16; ++r) { const int rho = crow(r, hi); const float gR = GC[32 + rho], bR = BT[32 + rho];
                const float n = (r32 < rho) ? bR * __expf(gR - gcC1) * kk11[r] : 0.f, nt = (rho < r32) ? bC1 * __expf(gcC1 - gR) * kk11[r] : 0.f;
                const float id = (rho == r32) ? 1.f : 0.f; P[r] = n; Pt[r] = nt; Tt[r] = id - nt; }
#pragma unroll
            for (int n = 0; n < 4; ++n) { Fr2 fP = frs(P), fPt = frs(Pt); const f32x16 z = {};
                P = mm(fPt, fP, z); Pt = mm(fP, fPt, z); fP = frs(P);
                const Fr2 fTt = frs(Tt); Tt = mm(fP, fTt, Tt); }
            T22t = Tt;
        }
        {
            f32x16 A21;
#pragma unroll
            for (int r = 0; r < 16; ++r) { const int rho = crow(r, hi); A21[r] = BT[32 + rho] * __expf(GC[32 + rho] - gcC0) * kk10[r]; }
            const f32x16 z = {};
            const f32x16 Z = mm(frs(A21), frs(T22t), z);
            const f32x16 t = mm(frs(T11), frs(Z), z);
#pragma unroll
            for (int r = 0; r < 16; ++r) T21t[r] = -t[r];
        }
        {
            f32x16 X11, X21, X22;
#pragma unroll
            for (int r = 0; r < 16; ++r) { const int rho = crow(r, hi); const float b0 = BT[rho], b1 = BT[32 + rho];
                X11[r] = b0 * T11t[r]; X21[r] = b0 * T21t[r]; X22[r] = b1 * T22t[r]; }
            {
                const LAS unsigned char* vb = Vimg + w4 * 4096 + lanepart;
                const bf16x8 v0 = trfrag(vb), v1 = trfrag(vb + 1024), v2 = trfrag(vb + 2048), v3 = trfrag(vb + 3072);
                const Fr2 f11 = frs(X11), f21 = frs(X21), f22 = frs(X22); f32x16 u0 = {}, u1 = {};
                u0 = MFMA32(f11.a, v0, u0); u0 = MFMA32(f11.b, v1, u0);
                u1 = MFMA32(f21.a, v0, u1); u1 = MFMA32(f21.b, v1, u1); u1 = MFMA32(f22.a, v2, u1); u1 = MFMA32(f22.b, v3, u1);
                bf16* up = F.DU + (((size_t)it * 2 + 0) * 4 + w4) * 1024 + lane * 16;
                *(v4u*)(up) = pack8r(u0, 0, 1.f); *(v4u*)(up + 8) = pack8r(u0, 1, 1.f);
                *(v4u*)(up + 4096) = pack8r(u1, 0, 1.f); *(v4u*)(up + 4096 + 8) = pack8r(u1, 1, 1.f);
            }
#pragma unroll
            for (int r = 0; r < 16; ++r) { const int rho = crow(r, hi); const float g0 = __expf(GC[rho]), g1 = __expf(GC[32 + rho]);
                X11[r] *= g0; X21[r] *= g0; X22[r] *= g1; }
            const LAS unsigned char* kb = Kimg + w4 * 4096 + lanepart;
            const bf16x8 k0 = trfrag(kb), k1 = trfrag(kb + 1024), k2 = trfrag(kb + 2048), k3 = trfrag(kb + 3072);
            {
                const Fr2 f11 = frs(X11), f21 = frs(X21), f22 = frs(X22); f32x16 w0 = {}, w1 = {};
                w0 = MFMA32(k0, f11.a, w0); w0 = MFMA32(k1, f11.b, w0);
                w1 = MFMA32(k0, f21.a, w1); w1 = MFMA32(k1, f21.b, w1); w1 = MFMA32(k2, f22.a, w1); w1 = MFMA32(k3, f22.b, w1);
                bf16* wp = F.DNWK + (size_t)it * 8192 + (size_t)r32 * 128 + (2 * w4) * 16 + 8 * hi;
                *(v4u*)(wp) = pack8r(w0, 0, -1.f); *(v4u*)(wp + 16) = pack8r(w0, 1, -1.f);
                *(v4u*)(wp + 32 * 128) = pack8r(w1, 0, -1.f); *(v4u*)(wp + 32 * 128 + 16) = pack8r(w1, 1, -1.f);
            }
            const float glast = GC[63];
            bf16* kd = F.DKDT + (size_t)it * 8192 + (size_t)(32 * w4 + r32) * 64 + 8 * hi;
#pragma unroll
            for (int G = 0; G < 4; ++G) { const bf16x8 kf = G == 0 ? k0 : G == 1 ? k1 : G == 2 ? k2 : k3; v4u w; float e[8];
#pragma unroll
                for (int q = 0; q < 8; ++q) { const int l = 16 * G + 8 * (q >> 2) + 4 * hi + (q & 3); e[q] = bf1((bf16)kf[q]) * __expf(glast - GC[l]); }
                w.x = cvtpk(e[0], e[1]); w.y = cvtpk(e[2], e[3]); w.z = cvtpk(e[4], e[5]); w.w = cvtpk(e[6], e[7]);
                *(v4u*)(kd + G * 16) = w; }
        }
        if (w4 < 3) {
            const int tp = w4 == 2 ? 1 : 0, tl = w4 == 0 ? 0 : 1;
            f32x16 a = {};
#pragma unroll
            for (int s = 0; s < 8; ++s) { const bf16x8 kf = *(const LAS bf16x8*)(Kimg + img_off(32 * tp + r32, 16 * s + 8 * hi)), qf = *(const LAS bf16x8*)(Qimg + img_off(32 * tl + r32, 16 * s + 8 * hi));
                a = MFMA32(kf, qf, a); }
            const int l = 32 * tl + r32; const float gl = GC[l];
#pragma unroll
            for (int r = 0; r < 16; ++r) { const int lp = 32 * tp + crow(r, hi); a[r] = (lp <= l) ? __expf(gl - GC[lp]) * a[r] : 0.f; }
            bf16* pp = F.DPQK + (size_t)it * 4096 + (size_t)l * 64 + (2 * tp) * 16 + 8 * hi;
            *(v4u*)(pp) = pack8r(a, 0, 1.f); *(v4u*)(pp + 16) = pack8r(a, 1, 1.f);
        }
#pragma unroll
        for (int k = 0; k < 2; ++k) { const int pi = lane + 64 * k, row = 16 * w4 + (pi >> 3), grp = pi & 7; const float gm = __expf(GC[row]);
            const v4u a = *(const LAS v4u*)(Qimg + img_off(row, 16 * grp)), bq = *(const LAS v4u*)(Qimg + img_off(row, 16 * grp + 8));
            v4u o0, o1;
            o0.x = cvtpk(bflo(a.x) * gm, bfhi(a.x) * gm); o0.y = cvtpk(bflo(a.y) * gm, bfhi(a.y) * gm); o0.z = cvtpk(bflo(bq.x) * gm, bfhi(bq.x) * gm); o0.w = cvtpk(bflo(bq.y) * gm, bfhi(bq.y) * gm);
            o1.x = cvtpk(bflo(a.z) * gm, bfhi(a.z) * gm); o1.y = cvtpk(bflo(a.w) * gm, bfhi(a.w) * gm); o1.z = cvtpk(bflo(bq.z) * gm, bfhi(bq.z) * gm); o1.w = cvtpk(bflo(bq.w) * gm, bfhi(bq.w) * gm);
            bf16* qp = F.DQG + (size_t)it * 8192 + (size_t)row * 128 + grp * 16; *(v4u*)qp = o0; *(v4u*)(qp + 8) = o1; }
        }
    }
    __syncthreads();
}

__device__ __forceinline__ void dn_scan(Frame& F, int bh) {
    using namespace dn;
    const int lane = F.lane, r32 = lane & 31, hi = lane >> 5, wid = F.wave;
    constexpr int BUF = 57344, B_NWK = 0, B_QG = 16384, B_KDT = 32768, B_PQK = 49152, OB_OFF = 2 * BUF, OB_BYTES = 16384;
    LAS unsigned char* shm = F.lds;
    const int b = bh >> 2, h = bh & 3; const size_t it0 = (size_t)bh * 32;
    if (wid >= 4) {
        const int j = wid - 4;
#define DN_DMA(c, buf) do { const size_t it_ = it0 + (c); LAS unsigned char* d_ = shm + (buf) * BUF; \
        _Pragma("unroll") for (int q = 0; q < 14; ++q) { const int p = j + 4 * q; const unsigned char* src; \
            if (q < 8) { const int pp = p & 15, l = 4 * pp + (lane >> 4), ci = (lane & 15) ^ (l & 15); src = (const unsigned char*)((q < 4 ? F.DNWK : F.DQG) + it_ * 8192) + l * 256 + ci * 16; } \
            else if (q < 12) { const int pp = p - 32, kf = 8 * pp + (lane >> 3), ci = (lane & 7) ^ (kf & 7); src = (const unsigned char*)(F.DKDT + it_ * 8192) + kf * 128 + ci * 16; } \
            else { const int pp = p - 48, l = 8 * pp + (lane >> 3), ci = (lane & 7) ^ (l & 7); src = (const unsigned char*)(F.DPQK + it_ * 4096) + l * 128 + ci * 16; } \
            glds16(src, (unsigned)__builtin_amdgcn_readfirstlane(LDS_ADDR(d_ + p * 1024))); } } while (0)
        DN_DMA(0, 0);
        asm volatile("s_waitcnt vmcnt(0)" ::: "memory"); __builtin_amdgcn_s_barrier(); asm volatile("" ::: "memory");
        const int prow = 16 * j + (lane >> 2), pq = lane & 3;
        v4u zw[4];
#pragma unroll
        for (int i = 0; i < 4; ++i) zw[i] = (v4u){0u, 0u, 0u, 0u};
#pragma unroll 1
        for (int c = 0; c <= 32; ++c) {
            asm volatile("" : "+v"(zw[0]), "+v"(zw[1]), "+v"(zw[2]), "+v"(zw[3]));
            if (c + 1 < 32) DN_DMA(c + 1, (c + 1) & 1);
            v4u zn[4];
            if (c < 32) { const bf16* zp = F.PROJ + ((size_t)b * SEQ + (size_t)c * CHK + prow) * NPROJ + C_Z + h * 128 + 32 * pq;
#pragma unroll
                for (int i = 0; i < 4; ++i) zn[i] = *(const v4u*)(zp + 8 * i); }
            else {
#pragma unroll
                for (int i = 0; i < 4; ++i) zn[i] = (v4u){0u, 0u, 0u, 0u}; }
            if (c >= 1) {
                const LAS unsigned char* ob = shm + OB_OFF + ((c - 1) & 1) * OB_BYTES + prow * 256;
                v4u ow[4]; float ss = 0.f;
#pragma unroll
                for (int i = 0; i < 4; ++i) { ow[i] = *(const LAS v4u*)(ob + (((4 * pq + i) ^ (prow & 15)) << 4));
                    ss += (bflo(ow[i].x) * bflo(ow[i].x) + bfhi(ow[i].x) * bfhi(ow[i].x)) + (bflo(ow[i].y) * bflo(ow[i].y) + bfhi(ow[i].y) * bfhi(ow[i].y))
                        + (bflo(ow[i].z) * bflo(ow[i].z) + bfhi(ow[i].z) * bfhi(ow[i].z)) + (bflo(ow[i].w) * bflo(ow[i].w) + bfhi(ow[i].w) * bfhi(ow[i].w)); }
                ss += dppf<0xB1>(ss); ss += dppf<0x4E>(ss);
                const float rs = __builtin_amdgcn_rsqf(ss * (1.f / 128.f) + EPS);
                bf16* yp = F.RA + ((size_t)b * SEQ + (size_t)(c - 1) * CHK + prow) * DM + 512 + h * 128 + 32 * pq;
#pragma unroll
                for (int i = 0; i < 4; ++i) { v4u y;
                    y.x = cvtpk(bflo(ow[i].x) * rs * bflo(zw[i].x), bfhi(ow[i].x) * rs * bfhi(zw[i].x)); y.y = cvtpk(bflo(ow[i].y) * rs * bflo(zw[i].y), bfhi(ow[i].y) * rs * bfhi(zw[i].y));
                    y.z = cvtpk(bflo(ow[i].z) * rs * bflo(zw[i].z), bfhi(ow[i].z) * rs * bfhi(zw[i].z)); y.w = cvtpk(bflo(ow[i].w) * rs * bflo(zw[i].w), bfhi(ow[i].w) * rs * bfhi(zw[i].w));
                    *(v4u*)(yp + 8 * i) = y; }
            }
            if (c < 32) { asm volatile("s_waitcnt vmcnt(0) lgkmcnt(0)" ::: "memory"); __builtin_amdgcn_s_barrier(); asm volatile("" ::: "memory"); }
#pragma unroll
            for (int i = 0; i < 4; ++i) zw[i] = zn[i];
        }
#undef DN_DMA
    } else {
        const int vt = wid;
        f32x16 st0 = {}, st1 = {}, st2 = {}, st3 = {};
        const bf16* ubase = F.DU + (it0 * 2 * 4 + vt) * 1024 + lane * 16;
        v4u un[4];
        un[0] = *(const v4u*)(ubase); un[1] = *(const v4u*)(ubase + 8); un[2] = *(const v4u*)(ubase + 4096); un[3] = *(const v4u*)(ubase + 4096 + 8);
        const int sw16 = r32 & 15, sw8 = r32 & 7;
        const float egl_all = F.EGL[it0 + (lane & 31)];
        asm volatile("" ::: "memory"); __builtin_amdgcn_s_barrier(); asm volatile("" ::: "memory");
#pragma unroll 1
        for (int c = 0; c < 32; ++c) {
            const LAS unsigned char* bb = shm + (c & 1) * BUF;
            f32x16 W0, W1;
#pragma unroll
            for (int q = 0; q < 4; ++q) { W0[2 * q] = bflo(un[0][q]); W0[2 * q + 1] = bfhi(un[0][q]); W0[8 + 2 * q] = bflo(un[1][q]); W0[9 + 2 * q] = bfhi(un[1][q]);
                W1[2 * q] = bflo(un[2][q]); W1[2 * q + 1] = bfhi(un[2][q]); W1[8 + 2 * q] = bflo(un[3][q]); W1[9 + 2 * q] = bfhi(un[3][q]); }
            if (c + 1 < 32) { const bf16* up = ubase + (size_t)(c + 1) * 8192; un[0] = *(const v4u*)(up); un[1] = *(const v4u*)(up + 8); un[2] = *(const v4u*)(up + 4096); un[3] = *(const v4u*)(up + 4096 + 8); }
            const float egl = __uint_as_float(__builtin_amdgcn_readlane(__float_as_uint(egl_all), c));
            bf16x8 Sf[8];
            Sf[0] = frag_of(st0, 0); Sf[1] = frag_of(st0, 1); Sf[2] = frag_of(st1, 0); Sf[3] = frag_of(st1, 1); Sf[4] = frag_of(st2, 0); Sf[5] = frag_of(st2, 1); Sf[6] = frag_of(st3, 0); Sf[7] = frag_of(st3, 1);
            const LAS unsigned char* nw0 = bb + B_NWK + r32 * 256, *nw1 = nw0 + 32 * 256;
            const LAS unsigned char* qg0 = bb + B_QG + r32 * 256, *qg1 = qg0 + 32 * 256;
            f32x16 O0 = {}, O1 = {};
#pragma unroll
            for (int G = 0; G < 8; ++G) { const int co = ((2 * G + hi) ^ sw16) * 16;
                W0 = MFMA32(*(const LAS bf16x8*)(nw0 + co), Sf[G], W0); W1 = MFMA32(*(const LAS bf16x8*)(nw1 + co), Sf[G], W1);
                O0 = MFMA32(*(const LAS bf16x8*)(qg0 + co), Sf[G], O0); O1 = MFMA32(*(const LAS bf16x8*)(qg1 + co), Sf[G], O1); }
            bf16x8 Wf[4]; Wf[0] = frag_of(W0, 0); Wf[1] = frag_of(W0, 1); Wf[2] = frag_of(W1, 0); Wf[3] = frag_of(W1, 1);
            const LAS unsigned char* pq0 = bb + B_PQK + r32 * 128, *pq1 = pq0 + 32 * 128;
#pragma unroll
            for (int G = 0; G < 2; ++G) O0 = MFMA32(*(const LAS bf16x8*)(pq0 + ((2 * G + hi) ^ sw8) * 16), Wf[G], O0);
#pragma unroll
            for (int G = 0; G < 4; ++G) O1 = MFMA32(*(const LAS bf16x8*)(pq1 + ((2 * G + hi) ^ sw8) * 16), Wf[G], O1);
            const LAS unsigned char* kd = bb + B_KDT + r32 * 128;
            st0 *= egl; st1 *= egl; st2 *= egl; st3 *= egl;
#pragma unroll
            for (int G = 0; G < 4; ++G) { const int co = ((2 * G + hi) ^ sw8) * 16;
                st0 = MFMA32(*(const LAS bf16x8*)(kd + co), Wf[G], st0); st1 = MFMA32(*(const LAS bf16x8*)(kd + 32 * 128 + co), Wf[G], st1);
                st2 = MFMA32(*(const LAS bf16x8*)(kd + 64 * 128 + co), Wf[G], st2); st3 = MFMA32(*(const LAS bf16x8*)(kd + 96 * 128 + co), Wf[G], st3); }
            LAS bf16* ob = (LAS bf16*)(shm + OB_OFF + (c & 1) * OB_BYTES);
#pragma unroll
            for (int r = 0; r < 16; ++r) { const int l = crow(r, hi); const int vs = (32 * vt + r32) ^ ((l & 15) << 3);
                ob[l * 128 + vs] = (bf16)f2bf(O0[r]); ob[(32 + l) * 128 + vs] = (bf16)f2bf(O1[r]); }
            asm volatile("s_waitcnt lgkmcnt(0)" ::: "memory"); __builtin_amdgcn_s_barrier(); asm volatile("" ::: "memory");
        }
    }
    __syncthreads();
}

__device__ __forceinline__ void p3_mix(Frame& F) {
    if ((F.vcu & 3) == 0) dn_scan(F, F.vcu >> 2);
    for (;;) {
        if (F.tid == 0) F.MISC[16] = __hip_atomic_fetch_add((unsigned*)(F.ctl + CW_ATTQ), 1u, RLX_AGENT);
        __syncthreads();
        const unsigned u = F.MISC[16];
        __syncthreads();
        if (u >= 1024u) break;
        int qg, bh;
        if (u < 768u) { qg = 2 + (int)(u >> 7); bh = (int)(u & 127u); } else if (u < 896u) { qg = 1; bh = (int)(u - 768u); } else { qg = 0; bh = (int)(u - 896u); }
        attn_unit(F, bh >> 3, bh & 7, qg);
    }
}

__device__ __forceinline__ void p11_final(Frame& F) {
    const int gw = F.vcu * NWAVES + F.wave, NGW = F.G * NWAVES;
    f32x4 gf[4];
#pragma unroll
    for (int j = 0; j < 2; ++j) { gf[2 * j] = *((const GAS f32x4*)F.g_final + 2 * F.lane + 128 * j); gf[2 * j + 1] = *((const GAS f32x4*)F.g_final + 2 * F.lane + 128 * j + 1); }
    v4u wn[2];
    { const GAS v4u* xr = (const GAS v4u*)(F.HFF + (size_t)gw * DM) + F.lane; wn[0] = xr[0]; wn[1] = xr[64]; }
    for (int m = gw; m < M; m += NGW) {
        const v4u w0 = wn[0], w1 = wn[1];
        if (m + NGW < M) { const GAS v4u* xr = (const GAS v4u*)(F.HFF + (size_t)(m + NGW) * DM) + F.lane; wn[0] = xr[0]; wn[1] = xr[64]; }
        f32x4 v[4];
        v[0] = (f32x4){bflo(w0.x), bfhi(w0.x), bflo(w0.y), bfhi(w0.y)}; v[1] = (f32x4){bflo(w0.z), bfhi(w0.z), bflo(w0.w), bfhi(w0.w)};
        v[2] = (f32x4){bflo(w1.x), bfhi(w1.x), bflo(w1.y), bfhi(w1.y)}; v[3] = (f32x4){bflo(w1.z), bfhi(w1.z), bflo(w1.w), bfhi(w1.w)};
        float s = 0.f;
#pragma unroll
        for (int j = 0; j < 4; ++j) s += (v[j].x * v[j].x + v[j].y * v[j].y) + (v[j].z * v[j].z + v[j].w * v[j].w);
        const float rstd = __builtin_amdgcn_rsqf(wave_sum(s) * (1.f / DM) + EPS);
        GAS f32x4* orow = (GAS f32x4*)(F.out + (size_t)m * DM);
        orow[2 * F.lane] = v[0] * rstd * gf[0]; orow[2 * F.lane + 1] = v[1] * rstd * gf[1];
        orow[128 + 2 * F.lane] = v[2] * rstd * gf[2]; orow[128 + 2 * F.lane + 1] = v[3] * rstd * gf[3];
    }
}

struct Args { const float* in[19]; float* out; unsigned char* ws; int ph_lo, ph_hi, li, pad; };
__global__ void __launch_bounds__(NWAVES * 64, 2) mk_fwd(Args args) {
    extern __shared__ __attribute__((aligned(16))) unsigned char lds[];
    Frame F;
    F.lds = (LAS unsigned char*)lds;
    F.MISC = (volatile LAS unsigned*)(F.lds + MISC_OFF);
    F.tid = threadIdx.x; F.lane = F.tid & 63; F.wave = __builtin_amdgcn_readfirstlane(F.tid >> 6);
    F.G = gridDim.x; { const int bx = blockIdx.x; F.vcu = (F.G % 8 == 0) ? (bx % 8) * (F.G / 8) + bx / 8 : bx; }
#define GRID_BAR(seam) do { if (N_LAUNCHES == PER_PHASE) { if (F.tid == 0) __hip_atomic_store(F.ctl + CW_TMO, 0xBADBA0u | (unsigned)(seam), RLX_AGENT); } \
    else { xcd_barrier(bar); } } while (0)
    unsigned char* ws = args.ws;
    F.ctl = (gu32*)(ws + WS_CTL);
    F.x = args.in[0]; F.p = args.in[1]; F.g_mix = args.in[2]; F.w_in = args.in[3]; F.conv_w = args.in[4]; F.a_log = args.in[5]; F.dt_bias = args.in[6]; F.rel_bias = args.in[7];
    F.w_onorm = args.in[8]; F.w_a = args.in[9]; F.w_b = args.in[10]; F.w_out = args.in[11]; F.g_ffn = args.in[12]; F.w_gu = args.in[13]; F.w_dn = args.in[14]; F.g_ple = args.in[15];
    F.w_pg = args.in[16]; F.w_pp = args.in[17]; F.g_final = args.in[18]; F.out = args.out;
    F.Win_t = (bf16*)(ws + WS_WIN); F.Wa_t = (bf16*)(ws + WS_WA); F.Wb_t = (bf16*)(ws + WS_WB); F.Wo_t = (bf16*)(ws + WS_WO); F.Wgu_t = (bf16*)(ws + WS_WGU);
    F.Wdn_t = (bf16*)(ws + WS_WDN); F.Wpg_t = (bf16*)(ws + WS_WPG); F.Wpp_t = (bf16*)(ws + WS_WPP);
    F.BD = (float*)(ws + WS_BD); F.SSQ1 = (float*)(ws + WS_SSQ1); F.SSQ2 = (float*)(ws + WS_SSQ2); F.EGL = (float*)(ws + WS_EGL); F.X = (float*)(ws + WS_X);
    F.PB = (bf16*)(ws + WS_PB); F.RA = (bf16*)(ws + WS_RA); F.PROJ = (bf16*)(ws + WS_PROJ); F.HFF = (bf16*)(ws + WS_HFF); F.PP = (bf16*)(ws + WS_PP);
    F.MERGED = (bf16*)args.out; F.TA = (bf16*)((unsigned char*)args.out + 64 * MiB);
    F.DU = (bf16*)args.out; F.DNWK = (bf16*)((unsigned char*)args.out + 32 * MiB); F.DQG = (bf16*)((unsigned char*)args.out + 64 * MiB); F.DKDT = (bf16*)((unsigned char*)args.out + 96 * MiB); F.DPQK = (bf16*)(ws + WS_PQK);
    for (int u = F.tid; u < (LDS_BYTES - LDSCTL_OFF) / 4; u += NWAVES * 64) ((LAS unsigned*)(F.lds + LDSCTL_OFF))[u] = 0u;
    __syncthreads();
    const int bli = (N_LAUNCHES == PER_PHASE) ? 0 : args.li;
    XcdBarrier bar; bar.bar = (unsigned*)(F.ctl + CW_BAR) + bli * XCD_BAR_WORDS; bar.x = 0; bar.st = nullptr;
    if (N_LAUNCHES != PER_PHASE) bar = xcd_barrier_post((unsigned*)(F.ctl + CW_BAR) + bli * XCD_BAR_WORDS, F.MISC + 8);

    const int lo = args.ph_lo, hi = args.ph_hi;
#define IN(k) (lo <= (k) && (k) < hi)
#define BOTH(k) (IN(k) && IN((k) + 1))
    using namespace pg8;
#define REFRESH() do { F.lane = lane_id(); F.tid = F.wave * 64 + F.lane; } while (0)
    if (IN(0)) { REFRESH(); p0_prologue(F); if (BOTH(0)) GRID_BAR(0); }
    if (IN(1)) {
        { Gemm g{F.RA, F.Win_t, M, C_Z, DM, DM, DM}; StaticOrder S; S.init(M, C_Z, F.G, (int)blockIdx.x);
          EpiBf16 E{F.PROJ, NPROJ};
          gemm_phase<EpiBf16, StaticOrder, PG8_ALIGN, PG8_SP2>(F.lds + RING_OFF, g, S, E, F.wave); }
        { Gemm g{F.RA, F.Win_t + (size_t)C_Z * DM, M, 512, DM, DM, DM}; StaticOrder S; S.init(M, 512, F.G, (int)blockIdx.x);
          EpiGate E{F.PROJ + C_Z, NPROJ, F.w_onorm};
          gemm_phase<EpiGate, StaticOrder, PG8_ALIGN, PG8_SP2>(F.lds + RING_OFF, g, S, E, F.wave); }
        if (BOTH(1)) GRID_BAR(1);
    }
    if (IN(2)) { REFRESH(); dn_prep(F); if (BOTH(2)) GRID_BAR(2); }
    if (IN(3)) { REFRESH(); p3_mix(F); if (BOTH(3)) GRID_BAR(3); }
    if (IN(4)) {
        Gemm g{F.RA, F.Wa_t, M, DM, DM, DM, DM}; StaticOrder S; S.init(M, DM, F.G, (int)blockIdx.x);
        EpiMergeF E{F.PROJ + C_GA, F.PROJ + C_GB, NPROJ, F.MERGED};
        gemm_phase<EpiMergeF, StaticOrder, PG8_ALIGN, PG8_SP2>(F.lds + RING_OFF, g, S, E, F.wave);
        late_weights_q<0>(F);
        if (BOTH(4)) GRID_BAR(4);
    }
    if (IN(6)) {
        Gemm g{F.MERGED, F.Wo_t, M, DM, DM, DM, DM}; StaticOrder S; S.init(M, DM, F.G, (int)blockIdx.x);
        EpiRes<false> E{F.x, nullptr, F.RA, F.SSQ1, nullptr};
        gemm_phase<EpiRes<false>, StaticOrder, PG8_ALIGN, PG8_SP2>(F.lds + RING_OFF, g, S, E, F.wave);
        late_weights_q<1>(F);
        if (BOTH(6)) GRID_BAR(6);
    }
    if (IN(7)) {
        Gemm g{F.RA, F.Wgu_t, M, 2 * DFF, DM, DM, DM}; StaticOrder S; S.init(M, 2 * DFF, F.G, (int)blockIdx.x);
        LAS float* rtab = (LAS float*)(F.lds + 131072);
        { REFRESH();
          for (int e = F.tid; e < 11 * 256; e += NWAVES * 64) { const int ui = e >> 8; Unit uu; if (S.next(ui, uu)) rtab[e] = rstd_from(F.SSQ1, uu.pm * 256 + (e & 255)); }
          __syncthreads(); }
        EpiSwiglu E{rtab, F.HFF, DFF};
        gemm_phase<EpiSwiglu, StaticOrder, PG8_ALIGN, PG8_SP2>(F.lds + RING_OFF, g, S, E, F.wave);
        late_weights_q<2>(F);
        if (BOTH(7)) GRID_BAR(7);
    }
    if (IN(8)) {
        Gemm g{F.HFF, F.Wdn_t, M, DM, DFF, DFF, DFF}; StaticOrder S; S.init(M, DM, F.G, (int)blockIdx.x);
        EpiRes<true> E{nullptr, F.RA, F.RA, F.SSQ2, (unsigned*)(F.ctl + CW_P8)};
        gemm_phase<EpiRes<true>, StaticOrder, PG8_ALIGN, PG8_SP2>(F.lds + RING_OFF, g, S, E, F.wave);
    }
    if (IN(10)) {
        { Gemm g{F.PB, F.Wpp_t, M, DM, PLE, PLE, PLE}; StaticOrder S; S.init(M, DM, F.G, (int)blockIdx.x);
          EpiBf16 E{F.PP, DM};
          gemm_phase<EpiBf16, StaticOrder, PG8_ALIGN, PG8_SP2>(F.lds + RING_OFF, g, S, E, F.wave); }
        Gemm g{F.RA, F.Wpg_t, M, DM, DM, DM, DM}; StaticOrder S; S.init(M, DM, F.G, (int)blockIdx.x);
        {
            if (F.wave == 0) { unsigned sp = 0;
                for (int i = 0; i < 4; ++i) { Unit uu; if (!S.next(i, uu)) break; unsigned* c = (unsigned*)(F.ctl + CW_P8) + 64 * uu.pm;
                    while ((unsigned)__builtin_amdgcn_readfirstlane(__hip_atomic_load(c, __ATOMIC_RELAXED, __HIP_MEMORY_SCOPE_AGENT)) < 4u) { __builtin_amdgcn_s_sleep(2); if (++sp > (1u << 20)) break; } }
                __builtin_amdgcn_fence(__ATOMIC_ACQUIRE, "agent"); asm volatile("s_waitcnt vmcnt(0)" ::: "memory"); }
            __syncthreads(); }
        EpiPleNorm E{F.SSQ2, F.RA, F.PP, F.out, (float*)(ws + WS_SSQ3), (unsigned*)(F.ctl + CW_PANEL), F.g_final};
        gemm_phase<EpiPleNorm, StaticOrder, PG8_ALIGN, PG8_SP2>(F.lds + RING_OFF, g, S, E, F.wave);
    }
#undef IN
#undef BOTH
}

extern "C" void kernel_launch(void* const* d_in, const int* in_sizes, int n_in, void* d_out, int out_size, void* d_ws, size_t ws_size, hipStream_t stream) {
    static int grid = 0;
    if (grid == 0) {
        if (n_in != 19 || in_sizes[0] != M * DM || out_size != M * DM || ws_size < WS_END) { fprintf(stderr, "kernel_launch: unexpected shapes: n_in %d in0 %d out %d ws %zu\n", n_in, n_in > 0 ? in_sizes[0] : -1, out_size, ws_size); grid = -1; return; }
        int dev = 0, cus = 0;
        if (hipGetDevice(&dev) != hipSuccess || hipDeviceGetAttribute(&cus, hipDeviceAttributeMultiprocessorCount, dev) != hipSuccess) { grid = -1; return; }
        if (hipFuncSetAttribute((const void*)mk_fwd, hipFuncAttributeMaxDynamicSharedMemorySize, LDS_BYTES) != hipSuccess) { fprintf(stderr, "kernel_launch: hipFuncSetAttribute failed\n"); grid = -1; return; }
        (void)hipGetLastError();
        grid = cus;
        if (grid != 256) fprintf(stderr, "kernel_launch: %d CUs (built for 256)\n", grid);
    }
    if (grid < 0) return;
    if (hipMemsetAsync((char*)d_ws + WS_CTL, 0, CTL_ZERO_BYTES, stream) != hipSuccess) return;
    Args a{};
    for (int i = 0; i < 19; ++i) a.in[i] = (const float*)d_in[i];
    a.out = (float*)d_out; a.ws = (unsigned char*)d_ws;
    for (int li = 0; li < N_LAUNCHES; ++li) {
        if (N_LAUNCHES == PER_PHASE) { a.ph_lo = li; a.ph_hi = li + 1; } else { a.ph_lo = 0; a.ph_hi = PER_PHASE; }
        a.li = li;
        hipLaunchKernelGGL(mk_fwd, dim3(grid), dim3(NWAVES * 64), LDS_BYTES, stream, a);
        const hipError_t le = hipPeekAtLastError();
        if (le != hipSuccess) { fprintf(stderr, "kernel_launch: launch %d failed: %s\n", li, hipGetErrorName(le)); break; }
    }
}
```

```cpp
#include <hip/hip_runtime.h>
#include <cstdio>
#include <cstdint>

#ifndef MK_N_LAUNCHES
#define MK_N_LAUNCHES 1
#endif

__device__ __forceinline__ int lane_id() { int l; asm volatile("v_mbcnt_lo_u32_b32 %0, -1, 0\n\tv_mbcnt_hi_u32_b32 %0, -1, %0" : "=v"(l)); return l; }
namespace pg8 {
#define PG8_LAS __attribute__((address_space(3)))
typedef unsigned short bf16_t;
typedef short bf16x8 __attribute__((ext_vector_type(8)));
typedef float f32x4 __attribute__((ext_vector_type(4)));
typedef unsigned u32x4 __attribute__((ext_vector_type(4)));
constexpr int BM = 256, BK = 64, HALF = 128, HTB = HALF * BK * 2, STAGE_BYTES = 8 * HTB, NXCD = 8, WGM = 8;

__host__ __device__ __forceinline__ int lds_byte(int r, int c) { const int st = (r >> 4) * 2 + (c >> 5), rr = r & 15, cc = c & 31, ob = rr * 64 + cc * 2; return st * 1024 + (ob ^ (((ob >> 9) & 1) << 5)); }
__host__ __device__ __forceinline__ void stage_rc(int b, int& R, int& C) { const int st = b / 1024, sb = b % 1024, swz = sb ^ (((sb >> 9) & 1) << 5); R = (st >> 1) * 16 + swz / 64; C = (st & 1) * 32 + (swz % 64) / 2; }
__host__ __device__ __forceinline__ int perm32(int rho) { const int n = rho >> 4, i = rho & 15; return 8 * (i >> 2) + 4 * n + (i & 3); }

struct Unit { int pm, pn, idx; };
struct Gemm { const bf16_t* A; const bf16_t* Bt; int M, N, K, lda, ldb; };

struct StaticOrder {
    int nM, nN, nwg, G, c;
    __host__ __device__ void init(int M, int N, int G_, int c_) { nM = M / BM; nN = N / BM; nwg = nM * nN; G = G_; c = c_; }
    __host__ __device__ bool next(int i, Unit& u) const {
        const long L = (long)i * G + c; if (L >= nwg) return false;
        int wgid = (int)L; { const int q = nwg / NXCD, r = nwg % NXCD, xcd = wgid % NXCD, off = wgid / NXCD; wgid = (xcd < r ? xcd * (q + 1) : r * (q + 1) + (xcd - r) * q) + off; }
        const int nig = WGM * nN, gid = wgid / nig, fm = gid * WGM, gsz = (nM - fm) < WGM ? (nM - fm) : WGM;
        u.pm = fm + ((wgid % nig) % gsz); u.pn = (wgid % nig) / gsz; u.idx = i; return true;
    }
    __device__ __forceinline__ void a_ready(const Unit&) const {}
    __device__ __forceinline__ void done(const Unit&) const {}
};

__device__ __forceinline__ unsigned cvt_pk_bf16(float lo, float hi) { unsigned r; asm volatile("v_cvt_pk_bf16_f32 %0, %1, %2" : "=v"(r) : "v"(lo), "v"(hi)); return r; }
__device__ __forceinline__ float bf_lo(unsigned u) { return __uint_as_float(u << 16); }
__device__ __forceinline__ float bf_hi(unsigned u) { return __uint_as_float(u & 0xffff0000u); }
__device__ __forceinline__ float sigm(float x) { return __builtin_amdgcn_rcpf(1.0f + __builtin_amdgcn_exp2f(-1.4426950408889634f * x)); }
__device__ __forceinline__ u32x4 pack8(const f32x4 a, const f32x4 b) { u32x4 w; w.x = cvt_pk_bf16(a[0], a[1]); w.y = cvt_pk_bf16(a[2], a[3]); w.z = cvt_pk_bf16(b[0], b[1]); w.w = cvt_pk_bf16(b[2], b[3]); return w; }
__device__ __forceinline__ void unpack8(const u32x4 w, f32x4& a, f32x4& b) { a = (f32x4){bf_lo(w.x), bf_hi(w.x), bf_lo(w.y), bf_hi(w.y)}; b = (f32x4){bf_lo(w.z), bf_hi(w.z), bf_lo(w.w), bf_hi(w.w)}; }
__device__ __forceinline__ float rstd_from(const float* ssq, int row) {
    const f32x4* p = (const f32x4*)(ssq + (size_t)row * 16);
    const f32x4 a = p[0], b = p[1], c = p[2], d = p[3];
    const float s = ((a[0] + a[1]) + (a[2] + a[3])) + ((b[0] + b[1]) + (b[2] + b[3])) + ((c[0] + c[1]) + (c[2] + c[3])) + ((d[0] + d[1]) + (d[2] + d[3]));
    return __builtin_amdgcn_rsqf(s * (1.0f / 1024.0f) + 1e-6f);
}

__device__ __forceinline__ float fq_sum(float v) {
    { const auto r = __builtin_amdgcn_permlane16_swap(__float_as_uint(v), __float_as_uint(v), false, false); v = __uint_as_float(r[0]) + __uint_as_float(r[1]); }
    { const auto r = __builtin_amdgcn_permlane32_swap(__float_as_uint(v), __float_as_uint(v), false, false); v = __uint_as_float(r[0]) + __uint_as_float(r[1]); }
    return v;
}
__device__ __forceinline__ void rstd8(const float* ssq, int row0, int fq, float (&r)[8]) {
    f32x4 p[8];
#pragma unroll
    for (int k = 0; k < 8; ++k) p[k] = *(const f32x4*)(ssq + (size_t)(row0 + (k >> 2) * HALF + (k & 3) * 16) * 16 + 4 * fq);
#pragma unroll
    for (int k = 0; k < 8; ++k) r[k] = __builtin_amdgcn_rsqf(fq_sum((p[k][0] + p[k][1]) + (p[k][2] + p[k][3])) * (1.0f / 1024.0f) + 1e-6f);
}
struct EpiBf16 {
    static constexpr bool PERM = true, AFTER_DRAIN = false, HAS_MID = false;
    bf16_t* O; int ldc;
    __device__ __forceinline__ void operator()(const f32x4 (&acc)[2][2][4][2], const Unit& u, int wr, int wc, int fr, int fq) const {
        const int row0 = u.pm * BM + wr * 64 + fr; const int col0 = u.pn * BM + wc * 32 + 8 * fq;
#pragma unroll
        for (int ai = 0; ai < 2; ++ai)
#pragma unroll
            for (int m = 0; m < 4; ++m) { bf16_t* rowp = O + (size_t)(row0 + ai * HALF + m * 16) * ldc + col0;
#pragma unroll
                for (int bj = 0; bj < 2; ++bj) *(u32x4*)(rowp + bj * HALF) = pack8(acc[ai][bj][m][0], acc[ai][bj][m][1]); }
    }
};
struct EpiGate {
    static constexpr bool PERM = true, AFTER_DRAIN = false, HAS_MID = false;
    bf16_t* O; int ldc; const float* wn;
    __device__ __forceinline__ void operator()(const f32x4 (&acc)[2][2][4][2], const Unit& u, int wr, int wc, int fr, int fq) const {
        const int row0 = u.pm * BM + wr * 64 + fr; const int col0 = u.pn * BM + wc * 32 + 8 * fq;
#pragma unroll
        for (int bj = 0; bj < 2; ++bj) { const f32x4 g0 = *(const f32x4*)(wn + ((col0 + bj * HALF) & 127)), g1 = *(const f32x4*)(wn + ((col0 + bj * HALF) & 127) + 4);
#pragma unroll
            for (int ai = 0; ai < 2; ++ai)
#pragma unroll
                for (int m = 0; m < 4; ++m) { f32x4 v0 = acc[ai][bj][m][0], v1 = acc[ai][bj][m][1];
#pragma unroll
                    for (int i = 0; i < 4; ++i) { v0[i] = v0[i] * sigm(v0[i]) * g0[i]; v1[i] = v1[i] * sigm(v1[i]) * g1[i]; }
                    *(u32x4*)(O + (size_t)(row0 + ai * HALF + m * 16) * ldc + col0 + bj * HALF) = pack8(v0, v1); } }
    }
};
struct EpiMergeF {
    static constexpr bool PERM = true, AFTER_DRAIN = false, HAS_MID = true;
    const bf16_t* ga; const bf16_t* gb; int ldg; bf16_t* OUT;
    __device__ __forceinline__ void mid(f32x4 (&acc)[2][2][4][2], const Unit& u, int wr, int wc, int fr, int fq) const {
        int opq = 0; asm volatile("" : "+v"(opq));
        const int row0 = u.pm * BM + wr * 64 + fr + opq; const int col0 = u.pn * BM + wc * 32 + 8 * fq;
#pragma unroll
        for (int ai = 0; ai < 2; ++ai) {
            u32x4 aw[4][2], bw[4][2];
#pragma unroll
            for (int m = 0; m < 4; ++m)
#pragma unroll
                for (int bj = 0; bj < 2; ++bj) { const size_t o = (size_t)(row0 + ai * HALF + m * 16) * ldg + col0 + bj * HALF; aw[m][bj] = *(const u32x4*)(ga + o); bw[m][bj] = *(const u32x4*)(gb + o); }
#pragma unroll
            for (int m = 0; m < 4; ++m)
#pragma unroll
                for (int bj = 0; bj < 2; ++bj) { f32x4 a0, a1, b0, b1; unpack8(aw[m][bj], a0, a1); unpack8(bw[m][bj], b0, b1);
#pragma unroll
                    for (int i = 0; i < 4; ++i) {
                        acc[ai][bj][m][0][i] *= (1.0f + __builtin_amdgcn_exp2f(-1.4426950408889634f * b0[i])) * __builtin_amdgcn_rcpf(1.0f + __builtin_amdgcn_exp2f(-1.4426950408889634f * a0[i]));
                        acc[ai][bj][m][1][i] *= (1.0f + __builtin_amdgcn_exp2f(-1.4426950408889634f * b1[i])) * __builtin_amdgcn_rcpf(1.0f + __builtin_amdgcn_exp2f(-1.4426950408889634f * a1[i])); } }
        }
    }
    __device__ __forceinline__ void operator()(const f32x4 (&acc)[2][2][4][2], const Unit& u, int wr, int wc, int fr, int fq) const {
        const int row0 = u.pm * BM + wr * 64 + fr; const int col0 = u.pn * BM + wc * 32 + 8 * fq;
        u32x4 bw[2][4][2];
#pragma unroll
        for (int ai = 0; ai < 2; ++ai)
#pragma unroll
            for (int m = 0; m < 4; ++m)
#pragma unroll
                for (int bj = 0; bj < 2; ++bj) bw[ai][m][bj] = *(const u32x4*)(gb + (size_t)(row0 + ai * HALF + m * 16) * ldg + col0 + bj * HALF);
#pragma unroll
        for (int ai = 0; ai < 2; ++ai)
#pragma unroll
            for (int m = 0; m < 4; ++m)
#pragma unroll
                for (int bj = 0; bj < 2; ++bj) { f32x4 b0, b1; unpack8(bw[ai][m][bj], b0, b1); f32x4 v0 = acc[ai][bj][m][0], v1 = acc[ai][bj][m][1];
#pragma unroll
                    for (int i = 0; i < 4; ++i) { v0[i] *= sigm(b0[i]); v1[i] *= sigm(b1[i]); }
                    bw[ai][m][bj] = pack8(v0, v1); }
#pragma unroll
        for (int ai = 0; ai < 2; ++ai)
#pragma unroll
            for (int m = 0; m < 4; ++m)
#pragma unroll
                for (int bj = 0; bj < 2; ++bj) *(u32x4*)(OUT + (size_t)(row0 + ai * HALF + m * 16) * 1024 + col0 + bj * HALF) = bw[ai][m][bj];
    }
};
template <bool BASE_BF16> struct EpiRes {
    static constexpr bool PERM = true, AFTER_DRAIN = false, HAS_MID = false;
    const float* base; const bf16_t* baseb; bf16_t* outb; float* ssq;
    __device__ __forceinline__ void operator()(const f32x4 (&acc)[2][2][4][2], const Unit& u, int wr, int wc, int fr, int fq) const {
        const int row0 = u.pm * BM + wr * 64 + fr; const int col0 = u.pn * BM + wc * 32 + 8 * fq;
        if constexpr (BASE_BF16) {
            u32x4 w[2][4][2]; float ss[8];
#pragma unroll
            for (int ai = 0; ai < 2; ++ai)
#pragma unroll
                for (int m = 0; m < 4; ++m)
#pragma unroll
                    for (int bj = 0; bj < 2; ++bj) w[ai][m][bj] = *(const u32x4*)(baseb + (size_t)(row0 + ai * HALF + m * 16) * 1024 + col0 + bj * HALF);
#pragma unroll
            for (int ai = 0; ai < 2; ++ai)
#pragma unroll
                for (int m = 0; m < 4; ++m) { float s = 0.f;
#pragma unroll
                    for (int bj = 0; bj < 2; ++bj) { f32x4 v0, v1; unpack8(w[ai][m][bj], v0, v1); v0 += acc[ai][bj][m][0]; v1 += acc[ai][bj][m][1]; w[ai][m][bj] = pack8(v0, v1);
                        s += (v0[0] * v0[0] + v0[1] * v0[1]) + (v0[2] * v0[2] + v0[3] * v0[3]) + (v1[0] * v1[0] + v1[1] * v1[1]) + (v1[2] * v1[2] + v1[3] * v1[3]); }
                    ss[ai * 4 + m] = fq_sum(s); }
#pragma unroll
            for (int ai = 0; ai < 2; ++ai)
#pragma unroll
                for (int m = 0; m < 4; ++m) { const size_t row = (size_t)(row0 + ai * HALF + m * 16);
#pragma unroll
                    for (int bj = 0; bj < 2; ++bj) *(u32x4*)(outb + row * 1024 + col0 + bj * HALF) = w[ai][m][bj];
                    if (fq == 0) ssq[row * 16 + u.pn * 4 + wc] = ss[ai * 4 + m]; }
        } else {
#pragma unroll
            for (int ai = 0; ai < 2; ++ai) {
                f32x4 b[4][2][2]; u32x4 w[4][2]; float ss[4];
#pragma unroll
                for (int m = 0; m < 4; ++m)
#pragma unroll
                    for (int bj = 0; bj < 2; ++bj) { const float* p = base + (size_t)(row0 + ai * HALF + m * 16) * 1024 + col0 + bj * HALF; b[m][bj][0] = __builtin_nontemporal_load((const f32x4*)p); b[m][bj][1] = __builtin_nontemporal_load((const f32x4*)(p + 4)); }
#pragma unroll
                for (int m = 0; m < 4; ++m) { float s = 0.f;
#pragma unroll
                    for (int bj = 0; bj < 2; ++bj) { const f32x4 v0 = b[m][bj][0] + acc[ai][bj][m][0], v1 = b[m][bj][1] + acc[ai][bj][m][1]; w[m][bj] = pack8(v0, v1);
                        s += (v0[0] * v0[0] + v0[1] * v0[1]) + (v0[2] * v0[2] + v0[3] * v0[3]) + (v1[0] * v1[0] + v1[1] * v1[1]) + (v1[2] * v1[2] + v1[3] * v1[3]); }
                    ss[m] = fq_sum(s); }
#pragma unroll
                for (int m = 0; m < 4; ++m) { const size_t row = (size_t)(row0 + ai * HALF + m * 16);
#pragma unroll
                    for (int bj = 0; bj < 2; ++bj) *(u32x4*)(outb + row * 1024 + col0 + bj * HALF) = w[m][bj];
                    if (fq == 0) ssq[row * 16 + u.pn * 4 + wc] = ss[m]; }
            }
        }
    }
};
struct EpiSwiglu {
    static constexpr bool PERM = true, AFTER_DRAIN = false, HAS_MID = false;
    const PG8_LAS float* rtab; bf16_t* H; int ldh;
    __device__ __forceinline__ void operator()(const f32x4 (&acc)[2][2][4][2], const Unit& u, int wr, int wc, int fr, int fq) const {
        const int row0 = u.pm * BM + wr * 64 + fr; const int col0 = u.pn * HALF + wc * 32 + 8 * fq;
        float r[8];
#pragma unroll
        for (int k = 0; k < 8; ++k) r[k] = rtab[u.idx * 256 + wr * 64 + fr + (k >> 2) * HALF + (k & 3) * 16];
        u32x4 w[8];
#pragma unroll
        for (int k = 0; k < 8; ++k) { const int ai = k >> 2, m = k & 3; f32x4 h0, h1;
#pragma unroll
            for (int i = 0; i < 4; ++i) { const float g0 = acc[ai][0][m][0][i] * r[k], g1 = acc[ai][0][m][1][i] * r[k];
                h0[i] = g0 * sigm(g0) * (acc[ai][1][m][0][i] * r[k]); h1[i] = g1 * sigm(g1) * (acc[ai][1][m][1][i] * r[k]); }
            w[k] = pack8(h0, h1); }
#pragma unroll
        for (int k = 0; k < 8; ++k) *(u32x4*)(H + (size_t)(row0 + (k >> 2) * HALF + (k & 3) * 16) * ldh + col0) = w[k];
    }
};
struct EpiPle {
    static constexpr bool PERM = true, AFTER_DRAIN = false, HAS_MID = false;
    const float* ssq; const bf16_t* base; const bf16_t* PP; bf16_t* out;
    __device__ __forceinline__ void operator()(const f32x4 (&acc)[2][2][4][2], const Unit& u, int wr, int wc, int fr, int fq) const {
        const int row0 = u.pm * BM + wr * 64 + fr; const int col0 = u.pn * BM + wc * 32 + 8 * fq;
#pragma unroll
        for (int ai = 0; ai < 2; ++ai)
#pragma unroll
            for (int m = 0; m < 4; ++m) { const int row = row0 + ai * HALF + m * 16; const float r = rstd_from(ssq, row);
#pragma unroll
                for (int bj = 0; bj < 2; ++bj) { const size_t off = (size_t)row * 1024 + col0 + bj * HALF;
                    const u32x4 pw = *(const u32x4*)(PP + off); f32x4 p0, p1; unpack8(pw, p0, p1);
                    const u32x4 bw = *(const u32x4*)(base + off); f32x4 v0, v1; unpack8(bw, v0, v1);
#pragma unroll
                    for (int i = 0; i < 4; ++i) { v0[i] += sigm(acc[ai][bj][m][0][i] * r) * p0[i]; v1[i] += sigm(acc[ai][bj][m][1][i] * r) * p1[i]; }
                    *(u32x4*)(out + off) = pack8(v0, v1); } }
    }
};

struct EpiPleNorm {
    static constexpr bool PERM = true, AFTER_DRAIN = false, HAS_MID = false;
    const float* ssq2; const bf16_t* base; const bf16_t* PP; float* out; float* ssq3; unsigned* cnt; const float* gfin;
    __device__ __forceinline__ void operator()(f32x4 (&acc)[2][2][4][2], const Unit& u, int wr, int wc, int fr, int fq) const {
        const int row0 = u.pm * BM + wr * 64 + fr; const int col0 = u.pn * BM + wc * 32 + 8 * fq;
        float r2[8], ss[8];
        u32x4 pw[4][2], bw[4][2];
        {
            f32x4 pr[8];
#pragma unroll
            for (int k = 0; k < 8; ++k) pr[k] = *(const f32x4*)(ssq2 + (size_t)(row0 + (k >> 2) * HALF + (k & 3) * 16) * 16 + 4 * fq);
#pragma unroll
            for (int m = 0; m < 4; ++m)
#pragma unroll
                for (int bj = 0; bj < 2; ++bj) { const size_t off = (size_t)(row0 + m * 16) * 1024 + col0 + bj * HALF; pw[m][bj] = *(const u32x4*)(PP + off); bw[m][bj] = *(const u32x4*)(base + off); }
#pragma unroll
            for (int k = 0; k < 8; ++k) r2[k] = __builtin_amdgcn_rsqf(fq_sum((pr[k][0] + pr[k][1]) + (pr[k][2] + pr[k][3])) * (1.0f / 1024.0f) + 1e-6f);
        }
#pragma unroll
        for (int ai = 0; ai < 2; ++ai) {
            if (ai == 1) {
#pragma unroll
                for (int m = 0; m < 4; ++m)
#pragma unroll
                    for (int bj = 0; bj < 2; ++bj) { const size_t off = (size_t)(row0 + HALF + m * 16) * 1024 + col0 + bj * HALF; pw[m][bj] = *(const u32x4*)(PP + off); bw[m][bj] = *(const u32x4*)(base + off); } }
#pragma unroll
            for (int m = 0; m < 4; ++m) { const float r = r2[ai * 4 + m]; float s = 0.f;
#pragma unroll
                for (int bj = 0; bj < 2; ++bj) { f32x4 p0, p1, v0, v1; unpack8(pw[m][bj], p0, p1); unpack8(bw[m][bj], v0, v1);
#pragma unroll
                    for (int i = 0; i < 4; ++i) { v0[i] += sigm(acc[ai][bj][m][0][i] * r) * p0[i]; v1[i] += sigm(acc[ai][bj][m][1][i] * r) * p1[i]; }
                    acc[ai][bj][m][0] = v0; acc[ai][bj][m][1] = v1;
                    s += (v0[0] * v0[0] + v0[1] * v0[1]) + (v0[2] * v0[2] + v0[3] * v0[3]) + (v1[0] * v1[0] + v1[1] * v1[1]) + (v1[2] * v1[2] + v1[3] * v1[3]); }
                ss[ai * 4 + m] = fq_sum(s); }
        }
        if (fq == 0) {
#pragma unroll
            for (int k = 0; k < 8; ++k) __hip_atomic_store(ssq3 + (size_t)(row0 + (k >> 2) * HALF + (k & 3) * 16) * 16 + u.pn * 4 + wc, ss[k], __ATOMIC_RELAXED, __HIP_MEMORY_SCOPE_AGENT); }
        asm volatile("s_waitcnt vmcnt(0)" ::: "memory");
        __builtin_amdgcn_s_barrier(); asm volatile("" ::: "memory");
        if (wr == 0 && wc == 0) {
            unsigned* c = cnt + 64 * u.pm;
            if (lane_id() == 0) __hip_atomic_fetch_add(c, 1u, __ATOMIC_RELAXED, __HIP_MEMORY_SCOPE_AGENT);
            unsigned sp = 0;
            while ((unsigned)__builtin_amdgcn_readfirstlane(__hip_atomic_load(c, __ATOMIC_RELAXED, __HIP_MEMORY_SCOPE_AGENT)) < 4u) { __builtin_amdgcn_s_sleep(2); if (++sp > (1u << 20)) break; }
            __builtin_amdgcn_fence(__ATOMIC_ACQUIRE, "agent");
            asm volatile("s_waitcnt vmcnt(0)" ::: "memory");
        }
        __builtin_amdgcn_s_barrier(); asm volatile("" ::: "memory");
        f32x4 g0[2], g1[2];
#pragma unroll
        for (int bj = 0; bj < 2; ++bj) { g0[bj] = *(const f32x4*)(gfin + col0 + bj * HALF); g1[bj] = *(const f32x4*)(gfin + col0 + bj * HALF + 4); }
        int opq = 0; asm volatile("" : "+v"(opq)); const int row1 = row0 + opq;
        float r3[8]; rstd8(ssq3, row1, fq, r3);
#pragma unroll
        for (int ai = 0; ai < 2; ++ai)
#pragma unroll
            for (int m = 0; m < 4; ++m) { const size_t row = (size_t)(row1 + ai * HALF + m * 16); const float r = r3[ai * 4 + m];
#pragma unroll
                for (int bj = 0; bj < 2; ++bj) { const size_t off = row * 1024 + col0 + bj * HALF;
                    *(f32x4*)(out + off) = acc[ai][bj][m][0] * r * g0[bj]; *(f32x4*)(out + off + 4) = acc[ai][bj][m][1] * r * g1[bj]; } }
    }
};

template <class Epi, class Sched, bool ALIGN_EPI = false, bool SP2 = false>
__device__ __forceinline__ void gemm_phase(PG8_LAS unsigned char* lds, const Gemm g, const Sched& S, const Epi& E, int wid) {
    const int lane = lane_id(), tid = wid * 64 + lane, wr = wid >> 2, wc = wid & 3, fr = lane & 15, fq = lane >> 4;
    const int K = g.K, nt = K / BK;
    unsigned voffA[2], voffB[2];
#pragma unroll
    for (int i = 0; i < 2; ++i) { int R, C; stage_rc(tid * 16 + i * 8192, R, C); const int Rb = Epi::PERM ? ((R & ~31) + perm32(R & 31)) : R;
        voffA[i] = (unsigned)(R * g.lda + C) * 2u; voffB[i] = (unsigned)(Rb * g.ldb + C) * 2u; }
    const size_t kstep = (size_t)(BK * 2);
    const size_t hstepA = (size_t)HALF * g.lda * 2, hstepB = (size_t)HALF * g.ldb * 2;
    const size_t tstepA = 2 * hstepA, tstepB = 2 * hstepB;
    const unsigned ldsw = (unsigned)wid * 1024u;
    const int aoff = lds_byte(wr * 64 + fr, fq * 8), boff = lds_byte(wc * 32 + fr, fq * 8);
#define PG8_SA(b, h) (((b) * 2 + (h)) * HTB)
#define PG8_SB(b, h) ((4 + (b) * 2 + (h)) * HTB)
#define PG8_STAGE(bufoff, gbase, voff) do { _Pragma("unroll") for (int _i = 0; _i < 2; ++_i) \
        __builtin_amdgcn_global_load_lds((const unsigned*)((const char*)(gbase) + (voff)[_i]), (PG8_LAS unsigned*)(lds + (bufoff) + ldsw + _i * 8192), 16, 0, 0); } while (0)
#define PG8_LDA(dst, b, h) do { _Pragma("unroll") for (int m = 0; m < 4; ++m) _Pragma("unroll") for (int k = 0; k < 2; ++k) dst[m][k] = *(const PG8_LAS bf16x8*)(lds + PG8_SA(b, h) + aoff + m * 2048 + k * 1024); } while (0)
#define PG8_LDB(dst, b, h) do { _Pragma("unroll") for (int n = 0; n < 2; ++n) _Pragma("unroll") for (int k = 0; k < 2; ++k) dst[n][k] = *(const PG8_LAS bf16x8*)(lds + PG8_SB(b, h) + boff + n * 2048 + k * 1024); } while (0)
#define PG8_MMA(ai, bj, At, Bt) do { __builtin_amdgcn_s_setprio(1); _Pragma("unroll") for (int m = 0; m < 4; ++m) _Pragma("unroll") for (int n = 0; n < 2; ++n) _Pragma("unroll") for (int k = 0; k < 2; ++k) \
        acc[ai][bj][m][n] = __builtin_amdgcn_mfma_f32_16x16x32_bf16(Bt[n][k], At[m][k], acc[ai][bj][m][n], 0, 0, 0); __builtin_amdgcn_s_setprio(0); } while (0)
#define PG8_WAIT_V(n) asm volatile("s_waitcnt vmcnt(" #n ")" ::: "memory")
#define PG8_WAIT_L(n) asm volatile("s_waitcnt lgkmcnt(" #n ")" ::: "memory")
#define PG8_BAR __builtin_amdgcn_s_barrier()
#define PG8_SCHED __builtin_amdgcn_sched_barrier(0)
    Unit cur, nxt; int ui = 0;
    if (!S.next(0, cur)) return;
    f32x4 acc[2][2][4][2];
#pragma unroll
    for (int a = 0; a < 2; ++a)
#pragma unroll
        for (int b = 0; b < 2; ++b)
#pragma unroll
            for (int m = 0; m < 4; ++m)
#pragma unroll
                for (int n = 0; n < 2; ++n) acc[a][b][m][n] = (f32x4){0.f, 0.f, 0.f, 0.f};
    bf16x8 At[4][2], B0[2][2], B1[2][2];
    const char* cA = (const char*)g.A + (size_t)cur.pm * tstepA; const char* cB = (const char*)g.Bt + (size_t)cur.pn * tstepB;
    S.a_ready(cur);
    if constexpr (SP2) {
        PG8_STAGE(PG8_SB(0, 0), cB, voffB); PG8_STAGE(PG8_SB(0, 1), cB + hstepB, voffB); PG8_STAGE(PG8_SA(0, 0), cA, voffA); PG8_STAGE(PG8_SA(0, 1), cA + hstepA, voffA);
        if (wr == 1) PG8_BAR;
        PG8_WAIT_V(2); PG8_BAR;
        PG8_STAGE(PG8_SB(1, 0), cB + kstep, voffB); PG8_STAGE(PG8_SA(1, 0), cA + kstep, voffA); PG8_STAGE(PG8_SB(1, 1), cB + hstepB + kstep, voffB);
        PG8_WAIT_V(6); PG8_BAR;
    } else {
        PG8_STAGE(PG8_SB(0, 0), cB, voffB); PG8_STAGE(PG8_SA(0, 0), cA, voffA); PG8_STAGE(PG8_SB(0, 1), cB + hstepB, voffB); PG8_STAGE(PG8_SA(0, 1), cA + hstepA, voffA);
        if (wr == 1) PG8_BAR;
        PG8_WAIT_V(4); PG8_BAR;
        PG8_STAGE(PG8_SB(1, 0), cB + kstep, voffB); PG8_STAGE(PG8_SA(1, 0), cA + kstep, voffA); PG8_STAGE(PG8_SB(1, 1), cB + hstepB + kstep, voffB);
        PG8_WAIT_V(6); PG8_BAR;
    }
    for (;;) {
        const bool has_next = S.next(ui + 1, nxt);
        const char* nA = has_next ? (const char*)g.A + (size_t)nxt.pm * tstepA : cA; const char* nB = has_next ? (const char*)g.Bt + (size_t)nxt.pn * tstepB : cB;
        for (int t = 0; t < nt; t += 2) {
            const bool last = (t == nt - 2);
            const char* a1 = cA + (size_t)(t + 1) * kstep;
            const char* a2 = last ? nA : cA + (size_t)(t + 2) * kstep; const char* b2 = last ? nB : cB + (size_t)(t + 2) * kstep;
            const char* a3 = a2 + kstep; const char* b3 = b2 + kstep;
            if (last && has_next) S.a_ready(nxt);
            if constexpr (Epi::HAS_MID) { if (t == nt / 2) E.mid(acc, cur, wr, wc, fr, fq); }
            if constexpr (SP2) {
            PG8_LDB(B0, 0, 0); PG8_LDB(B1, 0, 1); PG8_SCHED; PG8_LDA(At, 0, 0); PG8_STAGE(PG8_SA(1, 1), a1 + hstepA, voffA);
            PG8_WAIT_V(8); PG8_WAIT_L(0); PG8_BAR; PG8_MMA(0, 0, At, B0); PG8_MMA(0, 1, At, B1); PG8_BAR; PG8_SCHED;
            PG8_LDA(At, 0, 1); PG8_STAGE(PG8_SB(0, 0), b2, voffB); PG8_STAGE(PG8_SB(0, 1), b2 + hstepB, voffB); PG8_STAGE(PG8_SA(0, 0), a2, voffA);
            PG8_WAIT_V(8); PG8_WAIT_L(0); PG8_BAR; PG8_MMA(1, 0, At, B0); PG8_MMA(1, 1, At, B1); PG8_BAR; PG8_SCHED;
            PG8_LDB(B0, 1, 0); PG8_LDB(B1, 1, 1); PG8_SCHED; PG8_LDA(At, 1, 0); PG8_STAGE(PG8_SA(0, 1), a2 + hstepA, voffA);
            PG8_WAIT_V(8); PG8_WAIT_L(0); PG8_BAR; PG8_MMA(0, 0, At, B0); PG8_MMA(0, 1, At, B1); PG8_BAR; PG8_SCHED;
            PG8_LDA(At, 1, 1); PG8_STAGE(PG8_SB(1, 0), b3, voffB); PG8_STAGE(PG8_SB(1, 1), b3 + hstepB, voffB); PG8_STAGE(PG8_SA(1, 0), a3, voffA);
            PG8_WAIT_V(8); PG8_WAIT_L(0); PG8_BAR; PG8_MMA(1, 0, At, B0); PG8_MMA(1, 1, At, B1); PG8_BAR; PG8_SCHED;
            } else {
            PG8_LDB(B0, 0, 0); PG8_SCHED; PG8_LDA(At, 0, 0); PG8_STAGE(PG8_SA(1, 1), a1 + hstepA, voffA);
            PG8_WAIT_L(8); PG8_BAR; PG8_WAIT_L(0); PG8_MMA(0, 0, At, B0); PG8_BAR; PG8_SCHED;
            PG8_LDB(B1, 0, 1); PG8_STAGE(PG8_SB(0, 0), b2, voffB);
            PG8_BAR; PG8_WAIT_L(0); PG8_MMA(0, 1, At, B1); PG8_BAR;
            PG8_LDA(At, 0, 1); PG8_STAGE(PG8_SA(0, 0), a2, voffA);
            PG8_BAR; PG8_WAIT_L(0); PG8_MMA(1, 0, At, B0); PG8_BAR; PG8_SCHED;
            PG8_STAGE(PG8_SB(0, 1), b2 + hstepB, voffB);
            PG8_WAIT_V(6); PG8_BAR; PG8_MMA(1, 1, At, B1); PG8_BAR;
            PG8_LDB(B0, 1, 0); PG8_SCHED; PG8_LDA(At, 1, 0); PG8_STAGE(PG8_SA(0, 1), a2 + hstepA, voffA);
            PG8_WAIT_L(8); PG8_BAR; PG8_WAIT_L(0); PG8_MMA(0, 0, At, B0); PG8_BAR; PG8_SCHED;
            PG8_LDB(B1, 1, 1); PG8_STAGE(PG8_SB(1, 0), b3, voffB);
            PG8_BAR; PG8_WAIT_L(0); PG8_MMA(0, 1, At, B1); PG8_BAR;
            PG8_LDA(At, 1, 1); PG8_STAGE(PG8_SA(1, 0), a3, voffA);
            PG8_BAR; PG8_WAIT_L(0); PG8_MMA(1, 0, At, B0); PG8_BAR; PG8_SCHED;
            PG8_STAGE(PG8_SB(1, 1), b3 + hstepB, voffB);
            PG8_WAIT_V(6); PG8_BAR; PG8_MMA(1, 1, At, B1); PG8_BAR;
            }
        }
        if constexpr (ALIGN_EPI) { if (wr == 0) PG8_BAR; }
        if constexpr (!Epi::AFTER_DRAIN) { E(acc, cur, wr, wc, fr, fq); S.done(cur); }
        if (!has_next) break;
#pragma unroll
        for (int a = 0; a < 2; ++a)
#pragma unroll
            for (int b = 0; b < 2; ++b)
#pragma unroll
                for (int m = 0; m < 4; ++m)
#pragma unroll
                    for (int n = 0; n < 2; ++n) acc[a][b][m][n] = (f32x4){0.f, 0.f, 0.f, 0.f};
        cur = nxt; cA = nA; cB = nB; ++ui;
        if constexpr (ALIGN_EPI) { if (wr == 1) PG8_BAR; }
    }
    PG8_WAIT_V(0);
    if constexpr (!ALIGN_EPI) { if (wr == 0) PG8_BAR; }
    PG8_BAR;
#undef PG8_SA
#undef PG8_SB
#undef PG8_STAGE
#undef PG8_LDA
#undef PG8_LDB
#undef PG8_MMA
#undef PG8_WAIT_V
#undef PG8_WAIT_L
#undef PG8_BAR
#undef PG8_SCHED
}
}

#ifndef PG8_SP2
#define PG8_SP2 true
#endif
#ifndef PG8_ALIGN
#define PG8_ALIGN true
#endif

constexpr int NWAVES = 8;
constexpr int N_LAUNCHES = MK_N_LAUNCHES;
constexpr int PER_PHASE = 12;
constexpr int DM = 1024, BATCH = 16, SEQ = 2048, M = BATCH * SEQ, CHK = 64;
constexpr int DIN = 5640, NPROJ = 5632, DFF = 2816, PLE = 256;
constexpr int C_QA = 0, C_KA = 512, C_VA = 1024, C_CONV = 1536, C_GA = 3072, C_GB = 4096, C_Z = 5120;
constexpr int NREL = 257;
constexpr float EPS = 1e-6f;

constexpr size_t MiB = 1u << 20;
constexpr size_t WS_CTL = 0, CTL_ZERO_BYTES = 128 * 1024;
constexpr size_t WS_WIN = 1 * MiB;
constexpr size_t WS_WA = 12 * MiB, WS_WB = 13 * MiB;
constexpr size_t WS_WO = 14 * MiB;
constexpr size_t WS_WGU = 16 * MiB;
constexpr size_t WS_WDN = 27 * MiB;
constexpr size_t WS_WPG = 33 * MiB;
constexpr size_t WS_WPP = 35 * MiB;
constexpr size_t WS_BD = 36 * MiB;
constexpr size_t WS_PB = 37 * MiB;
constexpr size_t WS_SSQ1 = 53 * MiB, WS_SSQ2 = 55 * MiB;
constexpr size_t WS_SSQ3 = 60 * MiB;
constexpr size_t WS_EGL = 57 * MiB;
constexpr size_t WS_PQK = 480 * MiB;
constexpr int CW_ATTQ = 2048;
constexpr int CW_LATEQ = 3072;
constexpr int CW_PANEL = 16384;
constexpr size_t WS_RA = 64 * MiB;
constexpr size_t WS_PROJ = 128 * MiB;
constexpr size_t WS_X = 128 * MiB, WS_HFF = 256 * MiB, WS_PP = 432 * MiB;
constexpr size_t WS_END = 512 * MiB;
constexpr int CW_TMO = 0, CW_CODE = 1, CW_BAR = 4096;

constexpr int RING_OFF = 0, RING_BYTES = 147456;
constexpr int LDSCTL_OFF = RING_BYTES, MISC_OFF = LDSCTL_OFF + 320;
constexpr int LDS_BYTES = 149504;

#define GAS __attribute__((address_space(1)))
#define LAS __attribute__((address_space(3)))
typedef unsigned short bf16;
typedef unsigned v4u __attribute__((ext_vector_type(4)));
typedef float f32x4 __attribute__((ext_vector_type(4)));
typedef GAS unsigned gu32;
#define RLX_AGENT __ATOMIC_RELAXED, __HIP_MEMORY_SCOPE_AGENT
#define LDS_WAIT() asm volatile("s_waitcnt lgkmcnt(0)" ::: "memory")
#define VM_WAIT() asm volatile("s_waitcnt vmcnt(0)" ::: "memory")
__device__ __forceinline__ unsigned f2bf(float f) { unsigned u = __builtin_bit_cast(unsigned, f); return (u + 0x7fffu + ((u >> 16) & 1u)) >> 16; }
__device__ __forceinline__ unsigned pk2(float lo, float hi) { return f2bf(lo) | (f2bf(hi) << 16); }
__device__ __forceinline__ float bflo(unsigned u) { return __uint_as_float(u << 16); }
__device__ __forceinline__ float bfhi(unsigned u) { return __uint_as_float(u & 0xffff0000u); }
__device__ __forceinline__ float bf1(bf16 h) { return __uint_as_float(((unsigned)h) << 16); }
__device__ __forceinline__ void glds16(const void* gsrc, unsigned lds_dst) { unsigned keep;
    asm volatile("s_mov_b32 %0, m0\n\ts_mov_b32 m0, %2\n\ts_nop 0\n\tglobal_load_lds_dwordx4 %1, off\n\ts_mov_b32 m0, %0" : "=&s"(keep) : "v"(gsrc), "s"(lds_dst) : "memory"); }
#define LDS_ADDR(p) ((unsigned)(unsigned long)(p))

#define XB_TMO      128
#define XB_XCNT(j)  (256  + 64 * (j))
#define XB_XSUB(j)  (1280 + 64 * (j))
#define XB_XGEN(j)  (2304 + 64 * (j))
#define XB_TOP      3328
#define XB_TOPGEN   3392
#define XCD_BAR_WORDS 3456
#define XB_SPIN_CAP (1u << 18)
__device__ __forceinline__ unsigned xb_ld(unsigned* p)              { return __hip_atomic_load(p, __ATOMIC_RELAXED, __HIP_MEMORY_SCOPE_AGENT); }
__device__ __forceinline__ unsigned xb_add(unsigned* p, unsigned v) { return __hip_atomic_fetch_add(p, v, __ATOMIC_RELAXED, __HIP_MEMORY_SCOPE_AGENT); }
__device__ __forceinline__ unsigned xb_xcc_id() { return (unsigned)__builtin_amdgcn_s_getreg((3 << 11) | 20) & 0xFu; }
#define XB_SPIN(cond, bar) do { unsigned _sp = 0; while (cond) { __builtin_amdgcn_s_sleep(1); \
    if ((++_sp & 255u) == 0u) { if (xb_ld(&(bar)[XB_TMO])) break; if (_sp > XB_SPIN_CAP) { atomicAdd(&(bar)[XB_TMO], 1u); break; } } } } while (0)
struct XcdBarrier { unsigned* bar; unsigned x; volatile LAS unsigned* st; };
__device__ __forceinline__ XcdBarrier xcd_barrier_post(unsigned* bar, volatile LAS unsigned* st) {
    XcdBarrier b; b.bar = bar; b.x = xb_xcc_id(); b.st = st;
    if (threadIdx.x == 0) (void)xb_add(&bar[XB_XCNT(b.x)], 1u);
    return b;
}
__device__ __forceinline__ void xcd_barrier_complete(unsigned* bar, unsigned x, unsigned& nloc, unsigned& nx) {
    const unsigned G = gridDim.x * gridDim.y * gridDim.z;
    unsigned sum, cnt, mine, sp = 0u;
    for (;;) {
        sum = 0u; cnt = 0u; mine = 0u;
#pragma unroll
        for (unsigned j = 0; j < 16; ++j) { const unsigned c = xb_ld(&bar[XB_XCNT(j)]); sum += c; cnt += (c > 0u) ? 1u : 0u; mine = (j == x) ? c : mine; }
        if (sum == G) break;
        __builtin_amdgcn_s_sleep(1);
        if ((++sp & 255u) == 0u) { if (xb_ld(&bar[XB_TMO])) break; if (sp > XB_SPIN_CAP) { atomicAdd(&bar[XB_TMO], 1u); break; } }
    }
    nloc = mine > 0u ? mine : 1u; nx = cnt > 0u ? cnt : 1u;
}
__device__ __forceinline__ void xcd_barrier(const XcdBarrier& b) {
    asm volatile("s_waitcnt vmcnt(0)" ::: "memory");
    __syncthreads();
    if (threadIdx.x == 0) {
        unsigned* bar = b.bar;
        __builtin_amdgcn_s_waitcnt(0);
        unsigned nloc = b.st[0], nx = b.st[1];
        if (nloc == 0u) { xcd_barrier_complete(bar, b.x, nloc, nx); b.st[0] = nloc; b.st[1] = nx; }
        const unsigned old = xb_add(&bar[XB_XSUB(b.x)], 1u);
        const unsigned gen = old / nloc;
        if (old + 1u == (gen + 1u) * nloc) {
            __builtin_amdgcn_fence(__ATOMIC_RELEASE, "agent");
            asm volatile("s_waitcnt vmcnt(0)" ::: "memory");
            const unsigned og = xb_add(&bar[XB_TOP], 1u);
            const unsigned tg = og / nx;
            if (og + 1u == (tg + 1u) * nx) xb_add(&bar[XB_TOPGEN], 1u);
            else XB_SPIN(xb_ld(&bar[XB_TOPGEN]) == tg, bar);
            __builtin_amdgcn_fence(__ATOMIC_ACQUIRE, "agent");
            xb_add(&bar[XB_XGEN(b.x)], 1u);
            asm volatile("s_waitcnt vmcnt(0)" ::: "memory");
        } else {
            XB_SPIN(xb_ld(&bar[XB_XGEN(b.x)]) == gen, bar);
            __builtin_amdgcn_fence(__ATOMIC_ACQUIRE, "agent");
            asm volatile("s_waitcnt vmcnt(0)" ::: "memory");
        }
    }
    __syncthreads();
}

struct Frame {
    LAS unsigned char* lds;
    volatile LAS unsigned* MISC;
    gu32* ctl;
    int tid, lane, wave;
    int vcu, G;
    const float *x, *p, *g_mix, *w_in, *conv_w, *a_log, *dt_bias, *rel_bias, *w_onorm, *w_a, *w_b, *w_out, *g_ffn, *w_gu, *w_dn, *g_ple, *w_pg, *w_pp, *g_final;
    float* out;
    bf16 *Win_t, *Wa_t, *Wb_t, *Wo_t, *Wgu_t, *Wdn_t, *Wpg_t, *Wpp_t;
    float *BD, *SSQ1, *SSQ2, *EGL, *X;
    bf16 *PB, *RA, *PROJ, *HFF, *PP, *TA, *MERGED, *DU, *DNWK, *DQG, *DKDT, *DPQK;
};

template <int CTRL> __device__ __forceinline__ float dppf(float v) { return __builtin_bit_cast(float, __builtin_amdgcn_update_dpp(0, __builtin_bit_cast(int, v), CTRL, 0xf, 0xf, true)); }
__device__ __forceinline__ float row16_sum(float v) {
    v += dppf<0xB1>(v); v += dppf<0x4E>(v); v += dppf<0x141>(v); v += dppf<0x140>(v); return v;
}
__device__ __forceinline__ float half_swap_sum(float v) {
    const auto r = __builtin_amdgcn_permlane32_swap(__float_as_uint(v), __float_as_uint(v), false, false); return __uint_as_float(r[0]) + __uint_as_float(r[1]);
}
__device__ __forceinline__ float wave_sum(float v) {
    v = row16_sum(v);
    { const auto r = __builtin_amdgcn_permlane16_swap(__float_as_uint(v), __float_as_uint(v), false, false); v = __uint_as_float(r[0]) + __uint_as_float(r[1]); }
    return half_swap_sum(v);
}
__device__ __forceinline__ float sigm_(float x) { return __builtin_amdgcn_rcpf(1.0f + __builtin_amdgcn_exp2f(-1.4426950408889634f * x)); }

__device__ __forceinline__ void p0_transpose_blk(const float* W, int K, int Nsrc, bf16* WT, const float* g, int k0, int ns0, int nd0, LAS float* scr, int lane, int ldw = 0) {
    if (ldw == 0) ldw = K;
    const int n4 = (lane & 7) * 4, kr = lane >> 3;
    f32x4 w[8];
#pragma unroll
    for (int i = 0; i < 8; ++i) w[i] = __builtin_nontemporal_load((const f32x4*)(W + (size_t)(k0 + kr + 8 * i) * Nsrc + ns0 + n4));
#pragma unroll
    for (int i = 0; i < 8; ++i) { const int kk = kr + 8 * i; const float gs = g ? g[k0 + kk] : 1.f; LAS float* d = scr + kk * 33 + n4;
        d[0] = w[i][0] * gs; d[1] = w[i][1] * gs; d[2] = w[i][2] * gs; d[3] = w[i][3] * gs; }
    LDS_WAIT(); asm volatile("" ::: "memory");
    const int c = lane & 7;
#pragma unroll
    for (int j = 0; j < 4; ++j) { const int n = (lane >> 3) + 8 * j; const LAS float* s = scr + (8 * c) * 33 + n;
        v4u o; o.x = pk2(s[0 * 33], s[1 * 33]); o.y = pk2(s[2 * 33], s[3 * 33]); o.z = pk2(s[4 * 33], s[5 * 33]); o.w = pk2(s[6 * 33], s[7 * 33]);
        *(GAS v4u*)(WT + (size_t)(nd0 + n) * ldw + k0 + 8 * c) = o; }
    LDS_WAIT(); asm volatile("" ::: "memory");
}

template <int WHICH> __device__ __forceinline__ void late_weights_q(Frame& F) {
    LAS float* scr = (LAS float*)(F.lds + RING_OFF + F.wave * 16384);
    const int lane = lane_id();
    constexpr int I_GU = 16 * 176, I_DN = 44 * 32, I_PG = 16 * 32, I_PP = 4 * 32, I_PB = 2048;
    constexpr int NITEMS = WHICH == 0 ? I_GU : WHICH == 1 ? I_DN : I_PG + I_PP + I_PB;
    for (;;) {
        if (F.wave == 0 && lane == 0) F.MISC[18] = __hip_atomic_fetch_add((unsigned*)(F.ctl + CW_LATEQ + 64 * WHICH), 1u, RLX_AGENT);
        asm volatile("s_waitcnt lgkmcnt(0)" ::: "memory"); __builtin_amdgcn_s_barrier(); asm volatile("" ::: "memory");
        const unsigned tk = F.MISC[18];
        asm volatile("s_waitcnt lgkmcnt(0)" ::: "memory"); __builtin_amdgcn_s_barrier(); asm volatile("" ::: "memory");
        if ((int)tk * NWAVES >= NITEMS) break;
        int r = (int)tk * NWAVES + F.wave;
        if (r >= NITEMS) continue;
        if (WHICH == 0) { const int kb = r / 176, db = r % 176; const int tile = db >> 3, wi = db & 7; const int ns0 = wi < 4 ? 128 * tile + 32 * wi : DFF + 128 * tile + 32 * (wi - 4);
            p0_transpose_blk(F.w_gu, 1024, 2 * DFF, F.Wgu_t, F.g_ffn, 64 * kb, ns0, 32 * db, scr, lane); }
        else if (WHICH == 1) { const int kb = r / 32, db = r % 32; p0_transpose_blk(F.w_dn, DFF, 1024, F.Wdn_t, nullptr, 64 * kb, 32 * db, 32 * db, scr, lane); }
        else {
            if (r < I_PG) { const int kb = r / 32, db = r % 32; p0_transpose_blk(F.w_pg, 1024, 1024, F.Wpg_t, F.g_ple, 64 * kb, 32 * db, 32 * db, scr, lane); continue; } r -= I_PG;
            if (r < I_PP) { const int kb = r / 32, db = r % 32; p0_transpose_blk(F.w_pp, PLE, 1024, F.Wpp_t, nullptr, 64 * kb, 32 * db, 32 * db, scr, lane); continue; } r -= I_PP;
#pragma unroll
            for (int q = 0; q < 8; ++q) { const size_t i = (size_t)r * 512 + q * 64 + lane; const f32x4 a = __builtin_nontemporal_load((const f32x4*)F.p + 2 * i), b = __builtin_nontemporal_load((const f32x4*)F.p + 2 * i + 1);
                v4u o; o.x = pk2(a[0], a[1]); o.y = pk2(a[2], a[3]); o.z = pk2(b[0], b[1]); o.w = pk2(b[2], b[3]); *((v4u*)F.PB + i) = o; }
        }
    }
}

__device__ __forceinline__ void p0_prologue(Frame& F) {
    LAS float* scr = (LAS float*)(F.lds + RING_OFF + F.wave * 16384);
    const int gw = F.vcu * NWAVES + F.wave, NGW = F.G * NWAVES;
    constexpr int I_IN = 16 * 176, I_A = 8 * 32, I_O = 16 * 32;
    constexpr int NITEMS = I_IN + 2 * I_A + I_O;
    for (int it = gw; it < NITEMS; it += NGW) {
        int r = it;
        if (r < I_IN) { const int kb = r / 176, db = r % 176; const int ns0 = db < 96 ? 32 * db : (db < 160 ? 32 * (db - 96) + 3592 : 32 * (db - 160) + 3072); p0_transpose_blk(F.w_in, 1024, DIN, F.Win_t, nullptr, 64 * kb, ns0, 32 * db, scr, F.lane); continue; } r -= I_IN;
        if (r < I_A) { const int kb = r / 32, db = r % 32; p0_transpose_blk(F.w_a, 512, 1024, F.Wa_t, nullptr, 64 * kb, 32 * db, 32 * db, scr, F.lane, 1024); continue; } r -= I_A;
        if (r < I_A) { const int kb = r / 32, db = r % 32; p0_transpose_blk(F.w_b, 512, 1024, F.Wa_t + 512, nullptr, 64 * kb, 32 * db, 32 * db, scr, F.lane, 1024); continue; } r -= I_A;
        { const int kb = r / 32, db = r % 32; p0_transpose_blk(F.w_out, 1024, 1024, F.Wo_t, nullptr, 64 * kb, 32 * db, 32 * db, scr, F.lane); }
    }
    {
        __syncthreads();
        LAS float* wl = (LAS float*)(F.lds + RING_OFF);
        for (int k = F.tid; k < DM; k += NWAVES * 64) { const float* wr_ = F.w_in + (size_t)k * DIN + 3584; const f32x4 a = *(const f32x4*)wr_, b = *(const f32x4*)(wr_ + 4);
            wl[0 * DM + k] = a[0]; wl[1 * DM + k] = a[1]; wl[2 * DM + k] = a[2]; wl[3 * DM + k] = a[3]; wl[4 * DM + k] = b[0]; wl[5 * DM + k] = b[1]; wl[6 * DM + k] = b[2]; wl[7 * DM + k] = b[3]; }
        __syncthreads();
        f32x4 gm[4], wbd[8][4];
#pragma unroll
        for (int j = 0; j < 4; ++j) { gm[j] = *((const GAS f32x4*)F.g_mix + F.lane + 64 * j);
#pragma unroll
            for (int q = 0; q < 8; ++q) wbd[q][j] = *((const LAS f32x4*)(wl + q * DM) + F.lane + 64 * j); }
        f32x4 v[4], vn[4];
        { const GAS f32x4* xr = (const GAS f32x4*)(F.x + (size_t)gw * DM) + F.lane;
#pragma unroll
            for (int j = 0; j < 4; ++j) vn[j] = __builtin_nontemporal_load(xr + 64 * j); }
        for (int m = gw; m < M; m += NGW) {
#pragma unroll
            for (int j = 0; j < 4; ++j) v[j] = vn[j];
            if (m + NGW < M) { const GAS f32x4* xr = (const GAS f32x4*)(F.x + (size_t)(m + NGW) * DM) + F.lane;
#pragma unroll
                for (int j = 0; j < 4; ++j) vn[j] = __builtin_nontemporal_load(xr + 64 * j); }
            float s = 0.f;
#pragma unroll
            for (int j = 0; j < 4; ++j) s += (v[j].x * v[j].x + v[j].y * v[j].y) + (v[j].z * v[j].z + v[j].w * v[j].w);
            const float rstd = __builtin_amdgcn_rsqf(wave_sum(s) * (1.f / DM) + EPS);
            GAS unsigned long long* o8 = (GAS unsigned long long*)(F.RA + (size_t)m * DM) + F.lane;
            float d[8] = {0.f, 0.f, 0.f, 0.f, 0.f, 0.f, 0.f, 0.f};
#pragma unroll
            for (int j = 0; j < 4; ++j) { v[j] = v[j] * rstd * gm[j];
                o8[64 * j] = (unsigned long long)pk2(v[j].x, v[j].y) | ((unsigned long long)pk2(v[j].z, v[j].w) << 32);
#pragma unroll
                for (int q = 0; q < 8; ++q) d[q] += (v[j].x * wbd[q][j][0] + v[j].y * wbd[q][j][1]) + (v[j].z * wbd[q][j][2] + v[j].w * wbd[q][j][3]); }
#pragma unroll
            for (int q = 0; q < 8; ++q) d[q] = wave_sum(d[q]);
            if (F.lane == 0) { *(f32x4*)(F.BD + (size_t)m * 8) = (f32x4){d[0], d[1], d[2], d[3]}; *(f32x4*)(F.BD + (size_t)m * 8 + 4) = (f32x4){d[4], d[5], d[6], d[7]}; }
        }
    }
}

namespace att {
typedef short bf16x8 __attribute__((ext_vector_type(8)));
typedef short s16x4 __attribute__((ext_vector_type(4)));
typedef short v4i16_t __attribute__((ext_vector_type(4)));
typedef float f32x16 __attribute__((ext_vector_type(16)));
typedef float f32x2_t __attribute__((ext_vector_type(2)));
typedef __bf16 bf16x2_t __attribute__((ext_vector_type(2)));
constexpr int SLOTB = 8192, NSLOT = 5, LDS_K = 0, LDS_V = 40960, LDS_BIAS = 81920, LDS_WS = 83968, LDS_OST = 86016;
constexpr float LOG2E = 1.4426950408889634f, C2 = 0.125f * 1.4426950408889634f;
__device__ __forceinline__ int crow(int r, int hi) { return (r & 3) + 8 * (r >> 2) + 4 * hi; }
__device__ __forceinline__ unsigned cvtpk(float lo, float hi) { f32x2_t v = {lo, hi}; bf16x2_t b = __builtin_convertvector(v, bf16x2_t); return __builtin_bit_cast(unsigned, b); }
__device__ __forceinline__ s16x4 vtr(const LAS unsigned char* p) { return __builtin_bit_cast(s16x4, __builtin_amdgcn_ds_read_tr16_b64_v4i16((LAS v4i16_t*)p)); }
__device__ __forceinline__ bf16x8 frag_of(const f32x16& x, int s) { v4u w; w.x = cvtpk(x[8 * s], x[8 * s + 1]); w.y = cvtpk(x[8 * s + 2], x[8 * s + 3]); w.z = cvtpk(x[8 * s + 4], x[8 * s + 5]); w.w = cvtpk(x[8 * s + 6], x[8 * s + 7]); return __builtin_bit_cast(bf16x8, w); }
#define MFMA32(a, b, c) __builtin_amdgcn_mfma_f32_32x32x16_bf16((a), (b), (c), 0, 0, 0)
}

__device__ __forceinline__ void attn_unit(Frame& F, int b, int h, int qg) {
    using namespace att;
    const int tid = F.tid, lane = F.lane, r32 = lane & 31, hi = lane >> 5, wid = F.wave;
    LAS unsigned char* shm = F.lds;
    const int c0 = 4 * qg, cq = c0 + (wid >> 1), qi = (wid & 1) * 32 + r32;
    const size_t rowbase = (size_t)b * SEQ;
    LAS float* biasT = (LAS float*)(shm + LDS_BIAS);
    for (int i = tid; i < NREL; i += NWAVES * 64) biasT[i] = F.rel_bias[h * NREL + i] * LOG2E;
    const bf16* Qrow = F.PROJ + (rowbase + cq * 64 + qi) * NPROJ + C_QA + h * 64;
    bf16x8 qr[4];
#pragma unroll
    for (int d0 = 0; d0 < 4; ++d0) { const v4u w = *(const v4u*)(Qrow + d0 * 16 + hi * 8); v4u o;
        o.x = cvtpk(bflo(w.x) * C2, bfhi(w.x) * C2); o.y = cvtpk(bflo(w.y) * C2, bfhi(w.y) * C2); o.z = cvtpk(bflo(w.z) * C2, bfhi(w.z) * C2); o.w = cvtpk(bflo(w.w) * C2, bfhi(w.w) * C2);
        qr[d0] = __builtin_bit_cast(bf16x8, o); }
    const float bc = F.rel_bias[h * NREL + 256] * LOG2E;
    const int kc_lo = c0 >= 8 ? c0 - 8 : 0, kc_hi = c0 + 3;
    const bf16* ksrc = F.PROJ + (rowbase + 16 * (wid & 3) + (lane >> 2)) * NPROJ + C_KA + h * 64 + (wid >> 2) * 32 + (lane & 3) * 8;
    const bf16* vsrc = F.PROJ + (rowbase + 16 * (wid & 3) + (lane >> 2)) * NPROJ + C_VA + h * 64 + (wid >> 2) * 32 + (lane & 3) * 8;
#define ATT_DMA(kc, slot) do { \
        glds16(ksrc + (size_t)(kc) * 64 * NPROJ, (unsigned)__builtin_amdgcn_readfirstlane(LDS_ADDR(shm + LDS_K + (slot) * SLOTB + wid * 1024))); \
        glds16(vsrc + (size_t)(kc) * 64 * NPROJ, (unsigned)__builtin_amdgcn_readfirstlane(LDS_ADDR(shm + LDS_V + (slot) * SLOTB + wid * 1024))); } while (0)
    float mhat = 0.f; bool first = true;
    f32x16 o0 = {}, o1 = {}, lt = {}, cbm;
#pragma unroll
    for (int r = 0; r < 16; ++r) cbm[r] = bc;
    const bf16x8 ones = {0x3F80, 0x3F80, 0x3F80, 0x3F80, 0x3F80, 0x3F80, 0x3F80, 0x3F80};
    LAS float* wsf = (LAS float*)(shm + LDS_WS) + wid * 64;
    asm volatile("" : "+v"(qr[0]), "+v"(qr[1]), "+v"(qr[2]), "+v"(qr[3]), "+v"(cbm));
    LDS_WAIT();
    ATT_DMA(kc_lo, 0); ATT_DMA(kc_lo + 1, 1); ATT_DMA(kc_lo + 2, 2);
    const bool late = wid >= 4;
    bf16x8 pa0, pa1, pa2, pa3; bool pend = false; int pslot = 0;
    const int vlane = ((lane >> 4) & 1) * 32 + (lane & 3) * 8 + (4 * hi + ((lane & 15) >> 2)) * 64;
#define ATT_VF(d0, ks) ({ const s16x4 lo_ = vtr(vp + (d0) * 4096 + (ks) * 1024), hi_ = vtr(vp + (d0) * 4096 + (ks) * 1024 + 512); (bf16x8){lo_[0], lo_[1], lo_[2], lo_[3], hi_[0], hi_[1], hi_[2], hi_[3]}; })
#define ATT_PV(vslot) do { const LAS unsigned char* vp = shm + LDS_V + (vslot) * SLOTB + vlane; __builtin_amdgcn_s_setprio(1); \
        o0 = MFMA32(pa0, ATT_VF(0, 0), o0); o0 = MFMA32(pa1, ATT_VF(0, 1), o0); o0 = MFMA32(pa2, ATT_VF(0, 2), o0); o0 = MFMA32(pa3, ATT_VF(0, 3), o0); \
        o1 = MFMA32(pa0, ATT_VF(1, 0), o1); o1 = MFMA32(pa1, ATT_VF(1, 1), o1); o1 = MFMA32(pa2, ATT_VF(1, 2), o1); o1 = MFMA32(pa3, ATT_VF(1, 3), o1); \
        lt = MFMA32(pa0, ones, lt); lt = MFMA32(pa1, ones, lt); lt = MFMA32(pa2, ones, lt); lt = MFMA32(pa3, ones, lt); __builtin_amdgcn_s_setprio(0); } while (0)
    int slot = 0;
#pragma unroll 1
    for (int kc = kc_lo; kc <= kc_hi; ++kc) {
        if (kc + 2 <= kc_hi) asm volatile("s_waitcnt vmcnt(4)" ::: "memory"); else if (kc + 1 <= kc_hi) asm volatile("s_waitcnt vmcnt(2)" ::: "memory"); else asm volatile("s_waitcnt vmcnt(0)" ::: "memory");
        __builtin_amdgcn_s_barrier(); asm volatile("" ::: "memory");
        if (kc + 3 <= kc_hi) ATT_DMA(kc + 3, (slot + 3) % NSLOT);
        if (late && pend) { ATT_PV(pslot); pend = false; }
        if (kc >= cq - 8 && kc <= cq) {
            const LAS unsigned char* kb = shm + LDS_K + slot * SLOTB + (r32 >> 4) * 1024 + (r32 & 15) * 64 + hi * 16;
            const int dist = cq - kc;
            f32x16 p0, p1;
            if (dist >= 3) { p0 = cbm; p1 = cbm; }
            else {
#pragma unroll
                for (int r = 0; r < 16; ++r) { const int kk = crow(r, hi); int r0 = 64 * dist + qi - kk, r1 = r0 - 32;
                    r0 = r0 > 128 ? 128 : r0; r1 = r1 > 128 ? 128 : r1;
                    p0[r] = biasT[r0 + 128] - mhat; p1[r] = biasT[r1 + 128] - mhat; } }
            __builtin_amdgcn_s_setprio(1);
#pragma unroll
            for (int d0 = 0; d0 < 4; ++d0) {
                const bf16x8 b0 = *(const LAS bf16x8*)(kb + (d0 >> 1) * 4096 + (d0 & 1) * 32), b1 = *(const LAS bf16x8*)(kb + (d0 >> 1) * 4096 + (d0 & 1) * 32 + 2048);
                p0 = MFMA32(b0, qr[d0], p0); p1 = MFMA32(b1, qr[d0], p1); }
            __builtin_amdgcn_s_setprio(0);
            float rm = fmaxf(fmaxf(p0[0], p1[0]), fmaxf(p0[1], p1[1]));
#pragma unroll
            for (int r = 2; r < 16; r += 2) rm = fmaxf(rm, fmaxf(fmaxf(p0[r], p1[r]), fmaxf(p0[r + 1], p1[r + 1])));
            { const auto rr_ = __builtin_amdgcn_permlane32_swap(__float_as_uint(rm), __float_as_uint(rm), false, false); rm = fmaxf(__uint_as_float(rr_[0]), __uint_as_float(rr_[1])); }
            if (first || __any(rm > 6.0f)) {
                const float dl = first ? rm : fmaxf(rm, 0.f);
                mhat += dl;
#pragma unroll
                for (int r = 0; r < 16; ++r) { p0[r] -= dl; p1[r] -= dl; cbm[r] = bc - mhat; }
                if (!first) {
                    if (hi == 0) wsf[r32] = __builtin_amdgcn_exp2f(-dl);
                    LDS_WAIT(); asm volatile("" ::: "memory");
#pragma unroll
                    for (int r = 0; r < 16; ++r) { const float a = wsf[crow(r, hi)]; o0[r] *= a; o1[r] *= a; lt[r] *= a; }
                    LDS_WAIT(); asm volatile("" ::: "memory");
                }
                first = false;
            }
#pragma unroll
            for (int r = 0; r < 16; ++r) { p0[r] = __builtin_amdgcn_exp2f(p0[r]); p1[r] = __builtin_amdgcn_exp2f(p1[r]); }
            pa0 = frag_of(p0, 0); pa1 = frag_of(p0, 1); pa2 = frag_of(p1, 0); pa3 = frag_of(p1, 1);
            if (late) { pend = true; pslot = slot; } else { ATT_PV(slot); }
            LDS_WAIT(); asm volatile("" ::: "memory");
        }
        slot = (slot + 1 == NSLOT) ? 0 : slot + 1;
    }
    if (late && pend) { ATT_PV(pslot); LDS_WAIT(); asm volatile("" ::: "memory"); }
    {
        LAS bf16* stg = (LAS bf16*)(shm + LDS_OST) + wid * 2048;
#pragma unroll
        for (int r = 0; r < 16; ++r) { const int orow = crow(r, hi); const float rl = __builtin_amdgcn_rcpf(lt[r]);
            stg[orow * 64 + r32] = (bf16)f2bf(o0[r] * rl); stg[orow * 64 + 32 + r32] = (bf16)f2bf(o1[r] * rl); }
        LDS_WAIT(); asm volatile("" ::: "memory");
        bf16* Ow = F.RA + (rowbase + cq * 64 + (wid & 1) * 32) * DM + h * 64;
#pragma unroll
        for (int i = 0; i < 4; ++i) { const int row = i * 8 + (lane >> 3), ch = lane & 7; const v4u v = *(const LAS v4u*)(stg + row * 64 + ch * 8); *(v4u*)(Ow + (size_t)row * DM + ch * 8) = v; }
    }
    LDS_WAIT(); __builtin_amdgcn_s_barrier(); asm volatile("" ::: "memory");
#undef ATT_DMA
#undef ATT_VF
#undef ATT_PV
}

namespace dn {
using namespace att;
constexpr int IT_K = 0, IT_V = 16384, IT_Q = 32768, IT_GC = 49152, IT_BT = 49152 + 256, IT_BYTES = 51200;
__device__ __forceinline__ int img_off(int l, int f) { return (f >> 5) * 4096 + (l >> 4) * 1024 + (l & 15) * 64 + (f & 31) * 2; }
struct Fr2 { bf16x8 a, b; };
__device__ __forceinline__ Fr2 frs(const f32x16& x) { Fr2 f; f.a = frag_of(x, 0); f.b = frag_of(x, 1); return f; }
__device__ __forceinline__ f32x16 mm(const Fr2& A, const Fr2& B, f32x16 C) { C = MFMA32(A.a, B.a, C); return MFMA32(A.b, B.b, C); }
__device__ __forceinline__ bf16x8 trfrag(const LAS unsigned char* p) { const s16x4 lo_ = vtr(p), hi_ = vtr(p + 512); return (bf16x8){lo_[0], lo_[1], lo_[2], lo_[3], hi_[0], hi_[1], hi_[2], hi_[3]}; }
__device__ __forceinline__ v4u pack8r(const f32x16& x, int s, float sc) { v4u w; w.x = cvtpk(x[8 * s] * sc, x[8 * s + 1] * sc); w.y = cvtpk(x[8 * s + 2] * sc, x[8 * s + 3] * sc); w.z = cvtpk(x[8 * s + 4] * sc, x[8 * s + 5] * sc); w.w = cvtpk(x[8 * s + 6] * sc, x[8 * s + 7] * sc); return w; }
}

__device__ __forceinline__ void dn_prep(Frame& F) {
    using namespace dn;
    const int tid = F.tid, lane = F.lane, r32 = lane & 31, hi = lane >> 5, wid = F.wave, j = wid >> 2, w4 = wid & 3, t256 = tid & 255;
    LAS unsigned char* base = F.lds + j * IT_BYTES;
    LAS float* GC = (LAS float*)(base + IT_GC); LAS float* BT = (LAS float*)(base + IT_BT);
    const LAS unsigned char* Kimg = base + IT_K; const LAS unsigned char* Vimg = base + IT_V; const LAS unsigned char* Qimg = base + IT_Q;
    const int lanepart = ((lane >> 4) & 1) * 32 + (lane & 3) * 8 + (4 * hi + ((lane & 15) >> 2)) * 64;
    LAS float* cwl = (LAS float*)(F.lds + 2 * IT_BYTES);
    for (int i = tid; i < 4 * 1536 / 4; i += NWAVES * 64) ((LAS f32x4*)cwl)[i] = ((const f32x4*)F.conv_w)[i];
#pragma unroll 1
    for (int st = 0; st < 9; ++st) {
        asm volatile("s_waitcnt lgkmcnt(0)" ::: "memory"); __builtin_amdgcn_s_barrier(); asm volatile("" ::: "memory");
        const int ph = st - j; if (ph < 0 || ph >= 8) continue;
        const int iter = ph >> 1; const bool conv_stage = (ph & 1) == 0;
        const int it = (iter * 256 + (F.vcu & 255)) * 2 + j; const int bh = it >> 5, c = it & 31, b = bh >> 2, h = bh & 3; const size_t m0 = (size_t)b * SEQ + (size_t)c * CHK;
        if (conv_stage) {

        {
            const int g = t256 >> 4, c8 = t256 & 15;
            v4u xv[3][7];
#pragma unroll
            for (int part = 0; part < 3; ++part)
#pragma unroll
                for (int k = 0; k < 7; ++k) { const int row = 4 * g - 3 + k;
                    if (c * CHK + row >= 0) xv[part][k] = __builtin_nontemporal_load((const v4u*)(F.PROJ + (size_t)((long)m0 + row) * NPROJ + C_CONV + part * 512 + h * 128 + c8 * 8)); else xv[part][k] = (v4u){0u, 0u, 0u, 0u}; }
#pragma unroll
            for (int part = 0; part < 3; ++part) {
                f32x4 w0[4], w1[4];
#pragma unroll
                for (int i = 0; i < 4; ++i) { const LAS f32x4* wp = (const LAS f32x4*)(cwl + i * 1536 + part * 512 + h * 128 + c8 * 8); w0[i] = wp[0]; w1[i] = wp[1]; }
#pragma unroll
                for (int rr = 0; rr < 4; ++rr) {
                    float acc[8] = {0.f, 0.f, 0.f, 0.f, 0.f, 0.f, 0.f, 0.f};
#pragma unroll
                    for (int i = 0; i < 4; ++i) { const v4u xw = xv[part][rr + i];
                        acc[0] += bflo(xw.x) * w0[i][0]; acc[1] += bfhi(xw.x) * w0[i][1]; acc[2] += bflo(xw.y) * w0[i][2]; acc[3] += bfhi(xw.y) * w0[i][3];
                        acc[4] += bflo(xw.z) * w1[i][0]; acc[5] += bfhi(xw.z) * w1[i][1]; acc[6] += bflo(xw.w) * w1[i][2]; acc[7] += bfhi(xw.w) * w1[i][3]; }
                    float ss = 0.f;
#pragma unroll
                    for (int e = 0; e < 8; ++e) { acc[e] = acc[e] * sigm_(acc[e]); ss += acc[e] * acc[e]; }
                    if (part < 2) { ss = row16_sum(ss);
                        float rn = __builtin_amdgcn_rsqf(ss + EPS); if (part == 0) rn *= 0.08838834764831845f;
#pragma unroll
                        for (int e = 0; e < 8; ++e) acc[e] *= rn; }
                    v4u o; o.x = cvtpk(acc[0], acc[1]); o.y = cvtpk(acc[2], acc[3]); o.z = cvtpk(acc[4], acc[5]); o.w = cvtpk(acc[6], acc[7]);
                    *(LAS v4u*)(base + (part == 0 ? IT_Q : part == 1 ? IT_K : IT_V) + img_off(4 * g + rr, c8 * 8)) = o;
                }
            }
        }
        if (w4 == 0) {
            const size_t m = m0 + lane; const float br = F.BD[m * 8 + h], dr = F.BD[m * 8 + 4 + h] + F.dt_bias[h];
            const float sp = dr > 20.f ? dr : log1pf(expf(dr));
            float cs = -expf(F.a_log[h]) * sp;
#pragma unroll
            for (int o = 1; o < 64; o <<= 1) { const float t = __shfl_up(cs, o); if (lane >= o) cs += t; }
            GC[lane] = cs; BT[lane] = sigm_(br);
            if (lane == 63) F.EGL[it] = expf(cs);
        }
        } else {
        f32x16 kk00 = {}, kk11 = {}, kk10 = {};
#pragma unroll
        for (int s = 0; s < 8; ++s) { const bf16x8 ka = *(const LAS bf16x8*)(Kimg + img_off(r32, 16 * s + 8 * hi)), kb = *(const LAS bf16x8*)(Kimg + img_off(32 + r32, 16 * s + 8 * hi));
            kk00 = MFMA32(ka, ka, kk00); kk11 = MFMA32(kb, kb, kk11); kk10 = MFMA32(kb, ka, kk10); }
        const float gcC0 = GC[r32], gcC1 = GC[32 + r32], bC0 = BT[r32], bC1 = BT[32 + r32];
        f32x16 T11, T11t, T22t, T21t;
        {
            f32x16 P, Pt, T, Tt;
#pragma unroll
            for (int r = 0; r < 16; ++r) { const int rho = crow(r, hi); const float gR = GC[rho], bR = BT[rho];
                const float n = (r32 < rho) ? bR * __expf(gR - gcC0) * kk00[r] : 0.f, nt = (rho < r32) ? bC0 * __expf(gcC0 - gR) * kk00[r] : 0.f;
                const float id = (rho == r32) ? 1.f : 0.f; P[r] = n; Pt[r] = nt; T[r] = id - n; Tt[r] = id - nt; }
#pragma unroll
            for (int n = 0; n < 4; ++n) { Fr2 fP = frs(P), fPt = frs(Pt); const f32x16 z = {};
                P = mm(fPt, fP, z); Pt = mm(fP, fPt, z); fP = frs(P); fPt = frs(Pt);
                const Fr2 fT = frs(T), fTt = frs(Tt); T = mm(fPt, fT, T); Tt = mm(fP, fTt, Tt); }
            T11 = T; T11t = Tt;
        }
        {
            f32x16 P, Pt, Tt;
#pragma unroll
            for (int r = 0; r < 16; ++r) { const int rho = crow(r, hi); const float gR = GC[32 + rho], bR = BT[32 + rho];
                const float n = (r32 < rho) ? bR * __expf(gR - gcC1) * kk11[r] : 0.f, nt = (rho < r32) ? bC1 * __expf(gcC1 - gR) * kk11[r] : 0.f;
                const float id = (rho == r32) ? 1.f : 0.f; P[r] = n; Pt[r] = nt; Tt[r] = id - nt; }
#pragma unroll
            for (int n = 0; n < 4; ++n) { Fr2 fP = frs(P), fPt = frs(Pt); const f32x16 z = {};
                P = mm(fPt, fP, z); Pt = mm(fP, fPt, z); fP = frs(P);
                const Fr2 fTt = frs(Tt); Tt = mm(fP, fTt, Tt); }
            T22t = Tt;
        }
        {
            f32x16 A21;
#pragma unroll
            for (int r = 0; r < 16; ++r) { const int rho = crow(r, hi); A21[r] = BT[32 + rho] * __expf(GC[32 + rho] - gcC0) * kk10[r]; }
            const f32x16 z = {};
            const f32x16 Z = mm(frs(A21), frs(T22t), z);
            const f32x16 t = mm(frs(T11), frs(Z), z);
#pragma unroll
            for (int r = 0; r < 16; ++r) T21t[r] = -t[r];
        }
        {
            f32x16 X11, X21, X22;
#pragma unroll
            for (int r = 0; r < 16; ++r) { const int rho = crow(r, hi); const float b0 = BT[rho], b1 = BT[32 + rho];
                X11[r] = b0 * T11t[r]; X21[r] = b0 * T21t[r]; X22[r] = b1 * T22t[r]; }
            {
                const LAS unsigned char* vb = Vimg + w4 * 4096 + lanepart;
                const bf16x8 v0 = trfrag(vb), v1 = trfrag(vb + 1024), v2 = trfrag(vb + 2048), v3 = trfrag(vb + 3072);
                const Fr2 f11 = frs(X11), f21 = frs(X21), f22 = frs(X22); f32x16 u0 = {}, u1 = {};
                u0 = MFMA32(f11.a, v0, u0); u0 = MFMA32(f11.b, v1, u0);
                u1 = MFMA32(f21.a, v0, u1); u1 = MFMA32(f21.b, v1, u1); u1 = MFMA32(f22.a, v2, u1); u1 = MFMA32(f22.b, v3, u1);
                bf16* up = F.DU + (((size_t)it * 2 + 0) * 4 + w4) * 1024 + lane * 16;
                *(v4u*)(up) = pack8r(u0, 0, 1.f); *(v4u*)(up + 8) = pack8r(u0, 1, 1.f);
                *(v4u*)(up + 4096) = pack8r(u1, 0, 1.f); *(v4u*)(up + 4096 + 8) = pack8r(u1, 1, 1.f);
            }
#pragma unroll
            for (int r = 0; r < 16; ++r) { const int rho = crow(r, hi); const float g0 = __expf(GC[rho]), g1 = __expf(GC[32 + rho]);
                X11[r] *= g0; X21[r] *= g0; X22[r] *= g1; }
            const LAS unsigned char* kb = Kimg + w4 * 4096 + lanepart;
            const bf16x8 k0 = trfrag(kb), k1 = trfrag(kb + 1024), k2 = trfrag(kb + 2048), k3 = trfrag(kb + 3072);
            {
                const Fr2 f11 = frs(X11), f21 = frs(X21), f22 = frs(X22); f32x16 w0 = {}, w1 = {};
                w0 = MFMA32(k0, f11.a, w0); w0 = MFMA32(k1, f11.b, w0);
                w1 = MFMA32(k0, f21.a, w1); w1 = MFMA32(k1, f21.b, w1); w1 = MFMA32(k2, f22.a, w1); w1 = MFMA32(k3, f22.b, w1);
                bf16* wp = F.DNWK + (size_t)it * 8192 + (size_t)r32 * 128 + (2 * w4) * 16 + 8 * hi;
                *(v4u*)(wp) = pack8r(w0, 0, -1.f); *(v4u*)(wp + 16) = pack8r(w0, 1, -1.f);
                *(v4u*)(wp + 32 * 128) = pack8r(w1, 0, -1.f); *(v4u*)(wp + 32 * 128 + 16) = pack8r(w1, 1, -1.f);
            }
            const float glast = GC[63];
            bf16* kd = F.DKDT + (size_t)it * 8192 + (size_t)(32 * w4 + r32) * 64 + 8 * hi;
#pragma unroll
            for (int G = 0; G < 4; ++G) { const bf16x8 kf = G == 0 ? k0 : G == 1 ? k1 : G == 2 ? k2 : k3; v4u w; float e[8];
#pragma unroll
                for (int q = 0; q < 8; ++q) { const int l = 16 * G + 8 * (q >> 2) + 4 * hi + (q & 3); e[q] = bf1((bf16)kf[q]) * __expf(glast - GC[l]); }
                w.x = cvtpk(e[0], e[1]); w.y = cvtpk(e[2], e[3]); w.z = cvtpk(e[4], e[5]); w.w = cvtpk(e[6], e[7]);
                *(v4u*)(kd + G * 16) = w; }
        }
        if (w4 < 3) {
            const int tp = w4 == 2 ? 1 : 0, tl = w4 == 0 ? 0 : 1;
            f32x16 a = {};
#pragma unroll
            for (int s = 0; s < 8; ++s) { const bf16x8 kf = *(const LAS bf16x8*)(Kimg + img_off(32 * tp + r32, 16 * s + 8 * hi)), qf = *(const LAS bf16x8*)(Qimg + img_off(32 * tl + r32, 16 * s + 8 * hi));
                a = MFMA32(kf, qf, a); }
            const int l = 32 * tl + r32; const float gl = GC[l];
#pragma unroll
            for (int r = 0; r < 16; ++r) { const int lp = 32 * tp + crow(r, hi); a[r] = (lp <= l) ? __expf(gl - GC[lp]) * a[r] : 0.f; }
            bf16* pp = F.DPQK + (size_t)it * 4096 + (size_t)l * 64 + (2 * tp) * 16 + 8 * hi;
            *(v4u*)(pp) = pack8r(a, 0, 1.f); *(v4u*)(pp + 16) = pack8r(a, 1, 1.f);
        }
#pragma unroll
        for (int k = 0; k < 2; ++k) { const int pi = lane + 64 * k, row = 16 * w4 + (pi >> 3), grp = pi & 7; const float gm = __expf(GC[row]);
            const v4u a = *(const LAS v4u*)(Qimg + img_off(row, 16 * grp)), bq = *(const LAS v4u*)(Qimg + img_off(row, 16 * grp + 8));
            v4u o0, o1;
            o0.x = cvtpk(bflo(a.x) * gm, bfhi(a.x) * gm); o0.y = cvtpk(bflo(a.y) * gm, bfhi(a.y) * gm); o0.z = cvtpk(bflo(bq.x) * gm, bfhi(bq.x) * gm); o0.w = cvtpk(bflo(bq.y) * gm, bfhi(bq.y) * gm);
            o1.x = cvtpk(bflo(a.z) * gm, bfhi(a.z) * gm); o1.y = cvtpk(bflo(a.w) * gm, bfhi(a.w) * gm); o1.z = cvtpk(bflo(bq.z) * gm, bfhi(bq.z) * gm); o1.w = cvtpk(bflo(bq.w) * gm, bfhi(bq.w) * gm);
            bf16* qp = F.DQG + (size_t)it * 8192 + (size_t)row * 128 + grp * 16; *(v4u*)qp = o0; *(v4u*)(qp + 8) = o1; }
        }
    }
    __syncthreads();
}

__device__ __forceinline__ void dn_scan(Frame& F, int bh) {
    using namespace dn;
    const int lane = F.lane, r32 = lane & 31, hi = lane >> 5, wid = F.wave;
    constexpr int BUF = 57344, B_NWK = 0, B_QG = 16384, B_KDT = 32768, B_PQK = 49152, OB_OFF = 2 * BUF, OB_BYTES = 16384;
    LAS unsigned char* shm = F.lds;
    const int b = bh >> 2, h = bh & 3; const size_t it0 = (size_t)bh * 32;
    if (wid >= 4) {
        const int j = wid - 4;
#define DN_DMA(c, buf) do { const size_t it_ = it0 + (c); LAS unsigned char* d_ = shm + (buf) * BUF; \
        _Pragma("unroll") for (int q = 0; q < 14; ++q) { const int p = j + 4 * q; const unsigned char* src; \
            if (q < 8) { const int pp = p & 15, l = 4 * pp + (lane >> 4), ci = (lane & 15) ^ (l & 15); src = (const unsigned char*)((q < 4 ? F.DNWK : F.DQG) + it_ * 8192) + l * 256 + ci * 16; } \
            else if (q < 12) { const int pp = p - 32, kf = 8 * pp + (lane >> 3), ci = (lane & 7) ^ (kf & 7); src = (const unsigned char*)(F.DKDT + it_ * 8192) + kf * 128 + ci * 16; } \
            else { const int pp = p - 48, l = 8 * pp + (lane >> 3), ci = (lane & 7) ^ (l & 7); src = (const unsigned char*)(F.DPQK + it_ * 4096) + l * 128 + ci * 16; } \
            glds16(src, (unsigned)__builtin_amdgcn_readfirstlane(LDS_ADDR(d_ + p * 1024))); } } while (0)
        DN_DMA(0, 0);
        asm volatile("s_waitcnt vmcnt(0)" ::: "memory"); __builtin_amdgcn_s_barrier(); asm volatile("" ::: "memory");
        const int prow = 16 * j + (lane >> 2), pq = lane & 3;
        v4u zw[4];
#pragma unroll
        for (int i = 0; i < 4; ++i) zw[i] = (v4u){0u, 0u, 0u, 0u};
#pragma unroll 1
        for (int c = 0; c <= 32; ++c) {
            asm volatile("" : "+v"(zw[0]), "+v"(zw[1]), "+v"(zw[2]), "+v"(zw[3]));
            if (c + 1 < 32) DN_DMA(c + 1, (c + 1) & 1);
            v4u zn[4];
            if (c < 32) { const bf16* zp = F.PROJ + ((size_t)b * SEQ + (size_t)c * CHK + prow) * NPROJ + C_Z + h * 128 + 32 * pq;
#pragma unroll
                for (int i = 0; i < 4; ++i) zn[i] = *(const v4u*)(zp + 8 * i); }
            else {
#pragma unroll
                for (int i = 0; i < 4; ++i) zn[i] = (v4u){0u, 0u, 0u, 0u}; }
            if (c >= 1) {
                const LAS unsigned char* ob = shm + OB_OFF + ((c - 1) & 1) * OB_BYTES + prow * 256;
                v4u ow[4]; float ss = 0.f;
#pragma unroll
                for (int i = 0; i < 4; ++i) { ow[i] = *(const LAS v4u*)(ob + (((4 * pq + i) ^ (prow & 15)) << 4));
                    ss += (bflo(ow[i].x) * bflo(ow[i].x) + bfhi(ow[i].x) * bfhi(ow[i].x)) + (bflo(ow[i].y) * bflo(ow[i].y) + bfhi(ow[i].y) * bfhi(ow[i].y))
                        + (bflo(ow[i].z) * bflo(ow[i].z) + bfhi(ow[i].z) * bfhi(ow[i].z)) + (bflo(ow[i].w) * bflo(ow[i].w) + bfhi(ow[i].w) * bfhi(ow[i].w)); }
                ss += dppf<0xB1>(ss); ss += dppf<0x4E>(ss);
                const float rs = __builtin_amdgcn_rsqf(ss * (1.f / 128.f) + EPS);
                bf16* yp = F.RA + ((size_t)b * SEQ + (size_t)(c - 1) * CHK + prow) * DM + 512 + h * 128 + 32 * pq;
#pragma unroll
                for (int i = 0; i < 4; ++i) { v4u y;
                    y.x = cvtpk(bflo(ow[i].x) * rs * bflo(zw[i].x), bfhi(ow[i].x) * rs * bfhi(zw[i].x)); y.y = cvtpk(bflo(ow[i].y) * rs * bflo(zw[i].y), bfhi(ow[i].y) * rs * bfhi(zw[i].y));
                    y.z = cvtpk(bflo(ow[i].z) * rs * bflo(zw[i].z), bfhi(ow[i].z) * rs * bfhi(zw[i].z)); y.w = cvtpk(bflo(ow[i].w) * rs * bflo(zw[i].w), bfhi(ow[i].w) * rs * bfhi(zw[i].w));
                    *(v4u*)(yp + 8 * i) = y; }
            }
            if (c < 32) { asm volatile("s_waitcnt vmcnt(0) lgkmcnt(0)" ::: "memory"); __builtin_amdgcn_s_barrier(); asm volatile("" ::: "memory"); }
#pragma unroll
            for (int i = 0; i < 4; ++i) zw[i] = zn[i];
        }
#undef DN_DMA
    } else {
        const int vt = wid;
        f32x16 st0 = {}, st1 = {}, st2 = {}, st3 = {};
        const bf16* ubase = F.DU + (it0 * 2 * 4 + vt) * 1024 + lane * 16;
        v4u un[4];
        un[0] = *(const v4u*)(ubase); un[1] = *(const v4u*)(ubase + 8); un[2] = *(const v4u*)(ubase + 4096); un[3] = *(const v4u*)(ubase + 4096 + 8);
        const int sw16 = r32 & 15, sw8 = r32 & 7;
        const float egl_all = F.EGL[it0 + (lane & 31)];
        asm volatile("" ::: "memory"); __builtin_amdgcn_s_barrier(); asm volatile("" ::: "memory");
#pragma unroll 1
        for (int c = 0; c < 32; ++c) {
            const LAS unsigned char* bb = shm + (c & 1) * BUF;
            f32x16 W0, W1;
#pragma unroll
            for (int q = 0; q < 4; ++q) { W0[2 * q] = bflo(un[0][q]); W0[2 * q + 1] = bfhi(un[0][q]); W0[8 + 2 * q] = bflo(un[1][q]); W0[9 + 2 * q] = bfhi(un[1][q]);
                W1[2 * q] = bflo(un[2][q]); W1[2 * q + 1] = bfhi(un[2][q]); W1[8 + 2 * q] = bflo(un[3][q]); W1[9 + 2 * q] = bfhi(un[3][q]); }
            if (c + 1 < 32) { const bf16* up = ubase + (size_t)(c + 1) * 8192; un[0] = *(const v4u*)(up); un[1] = *(const v4u*)(up + 8); un[2] = *(const v4u*)(up + 4096); un[3] = *(const v4u*)(up + 4096 + 8); }
            const float egl = __uint_as_float(__builtin_amdgcn_readlane(__float_as_uint(egl_all), c));
            bf16x8 Sf[8];
            Sf[0] = frag_of(st0, 0); Sf[1] = frag_of(st0, 1); Sf[2] = frag_of(st1, 0); Sf[3] = frag_of(st1, 1); Sf[4] = frag_of(st2, 0); Sf[5] = frag_of(st2, 1); Sf[6] = frag_of(st3, 0); Sf[7] = frag_of(st3, 1);
            const LAS unsigned char* nw0 = bb + B_NWK + r32 * 256, *nw1 = nw0 + 32 * 256;
            const LAS unsigned char* qg0 = bb + B_QG + r32 * 256, *qg1 = qg0 + 32 * 256;
            f32x16 O0 = {}, O1 = {};
#pragma unroll
            for (int G = 0; G < 8; ++G) { const int co = ((2 * G + hi) ^ sw16) * 16;
                W0 = MFMA32(*(const LAS bf16x8*)(nw0 + co), Sf[G], W0); W1 = MFMA32(*(const LAS bf16x8*)(nw1 + co), Sf[G], W1);
                O0 = MFMA32(*(const LAS bf16x8*)(qg0 + co), Sf[G], O0); O1 = MFMA32(*(const LAS bf16x8*)(qg1 + co), Sf[G], O1); }
            bf16x8 Wf[4]; Wf[0] = frag_of(W0, 0); Wf[1] = frag_of(W0, 1); Wf[2] = frag_of(W1, 0); Wf[3] = frag_of(W1, 1);
            const LAS unsigned char* pq0 = bb + B_PQK + r32 * 128, *pq1 = pq0 + 32 * 128;
#pragma unroll
            for (int G = 0; G < 2; ++G) O0 = MFMA32(*(const LAS bf16x8*)(pq0 + ((2 * G + hi) ^ sw8) * 16), Wf[G], O0);
#pragma unroll
            for (int G = 0; G < 4; ++G) O1 = MFMA32(*(const LAS bf16x8*)(pq1 + ((2 * G + hi) ^ sw8) * 16), Wf[G], O1);
            const LAS unsigned char* kd = bb + B_KDT + r32 * 128;
            st0 *= egl; st1 *= egl; st2 *= egl; st3 *= egl;
#pragma unroll
            for (int G = 0; G < 4; ++G) { const int co = ((2 * G + hi) ^ sw8) * 16;
                st0 = MFMA32(*(const LAS bf16x8*)(kd + co), Wf[G], st0); st1 = MFMA32(*(const LAS bf16x8*)(kd + 32 * 128 + co), Wf[G], st1);
                st2 = MFMA32(*(const LAS bf16x8*)(kd + 64 * 128 + co), Wf[G], st2); st3 = MFMA32(*(const LAS bf16x8*)(kd + 96 * 128 + co), Wf[G], st3); }
            LAS bf16* ob = (LAS bf16*)(shm + OB_OFF + (c & 1) * OB_BYTES);
#pragma unroll
            for (int r = 0; r < 16; ++r) { const int l = crow(r, hi); const int vs = (32 * vt + r32) ^ ((l & 15) << 3);
                ob[l * 128 + vs] = (bf16)f2bf(O0[r]); ob[(32 + l) * 128 + vs] = (bf16)f2bf(O1[r]); }
            asm volatile("s_waitcnt lgkmcnt(0)" ::: "memory"); __builtin_amdgcn_s_barrier(); asm volatile("" ::: "memory");
        }
    }
    __syncthreads();
}

__device__ __forceinline__ void p3_mix(Frame& F) {
    if ((F.vcu & 3) == 0) dn_scan(F, F.vcu >> 2);
    for (;;) {
        if (F.tid == 0) F.MISC[16] = __hip_atomic_fetch_add((unsigned*)(F.ctl + CW_ATTQ), 1u, RLX_AGENT);
        __syncthreads();
        const unsigned u = F.MISC[16];
        __syncthreads();
        if (u >= 1024u) break;
        int qg, bh;
        if (u < 768u) { qg = 2 + (int)(u >> 7); bh = (int)(u & 127u); } else if (u < 896u) { qg = 1; bh = (int)(u - 768u); } else { qg = 0; bh = (int)(u - 896u); }
        attn_unit(F, bh >> 3, bh & 7, qg);
    }
}

__device__ __forceinline__ void p11_final(Frame& F) {
    const int gw = F.vcu * NWAVES + F.wave, NGW = F.G * NWAVES;
    f32x4 gf[4];
#pragma unroll
    for (int j = 0; j < 2; ++j) { gf[2 * j] = *((const GAS f32x4*)F.g_final + 2 * F.lane + 128 * j); gf[2 * j + 1] = *((const GAS f32x4*)F.g_final + 2 * F.lane + 128 * j + 1); }
    v4u wn[2];
    { const GAS v4u* xr = (const GAS v4u*)(F.HFF + (size_t)gw * DM) + F.lane; wn[0] = xr[0]; wn[1] = xr[64]; }
    for (int m = gw; m < M; m += NGW) {
        const v4u w0 = wn[0], w1 = wn[1];
        if (m + NGW < M) { const GAS v4u* xr = (const GAS v4u*)(F.HFF + (size_t)(m + NGW) * DM) + F.lane; wn[0] = xr[0]; wn[1] = xr[64]; }
        f32x4 v[4];
        v[0] = (f32x4){bflo(w0.x), bfhi(w0.x), bflo(w0.y), bfhi(w0.y)}; v[1] = (f32x4){bflo(w0.z), bfhi(w0.z), bflo(w0.w), bfhi(w0.w)};
        v[2] = (f32x4){bflo(w1.x), bfhi(w1.x), bflo(w1.y), bfhi(w1.y)}; v[3] = (f32x4){bflo(w1.z), bfhi(w1.z), bflo(w1.w), bfhi(w1.w)};
        float s = 0.f;
#pragma unroll
        for (int j = 0; j < 4; ++j) s += (v[j].x * v[j].x + v[j].y * v[j].y) + (v[j].z * v[j].z + v[j].w * v[j].w);
        const float rstd = __builtin_amdgcn_rsqf(wave_sum(s) * (1.f / DM) + EPS);
        GAS f32x4* orow = (GAS f32x4*)(F.out + (size_t)m * DM);
        orow[2 * F.lane] = v[0] * rstd * gf[0]; orow[2 * F.lane + 1] = v[1] * rstd * gf[1];
        orow[128 + 2 * F.lane] = v[2] * rstd * gf[2]; orow[128 + 2 * F.lane + 1] = v[3] * rstd * gf[3];
    }
}

struct Args { const float* in[19]; float* out; unsigned char* ws; int ph_lo, ph_hi, li, pad; };
__global__ void __launch_bounds__(NWAVES * 64, 2) mk_fwd(Args args) {
    extern __shared__ __attribute__((aligned(16))) unsigned char lds[];
    Frame F;
    F.lds = (LAS unsigned char*)lds;
    F.MISC = (volatile LAS unsigned*)(F.lds + MISC_OFF);
    F.tid = threadIdx.x; F.lane = F.tid & 63; F.wave = __builtin_amdgcn_readfirstlane(F.tid >> 6);
    F.G = gridDim.x; { const int bx = blockIdx.x; F.vcu = (F.G % 8 == 0) ? (bx % 8) * (F.G / 8) + bx / 8 : bx; }
#define GRID_BAR(seam) do { if (N_LAUNCHES == PER_PHASE) { if (F.tid == 0) __hip_atomic_store(F.ctl + CW_TMO, 0xBADBA0u | (unsigned)(seam), RLX_AGENT); } \
    else { xcd_barrier(bar); } } while (0)
    unsigned char* ws = args.ws;
    F.ctl = (gu32*)(ws + WS_CTL);
    F.x = args.in[0]; F.p = args.in[1]; F.g_mix = args.in[2]; F.w_in = args.in[3]; F.conv_w = args.in[4]; F.a_log = args.in[5]; F.dt_bias = args.in[6]; F.rel_bias = args.in[7];
    F.w_onorm = args.in[8]; F.w_a = args.in[9]; F.w_b = args.in[10]; F.w_out = args.in[11]; F.g_ffn = args.in[12]; F.w_gu = args.in[13]; F.w_dn = args.in[14]; F.g_ple = args.in[15];
    F.w_pg = args.in[16]; F.w_pp = args.in[17]; F.g_final = args.in[18]; F.out = args.out;
    F.Win_t = (bf16*)(ws + WS_WIN); F.Wa_t = (bf16*)(ws + WS_WA); F.Wb_t = (bf16*)(ws + WS_WB); F.Wo_t = (bf16*)(ws + WS_WO); F.Wgu_t = (bf16*)(ws + WS_WGU);
    F.Wdn_t = (bf16*)(ws + WS_WDN); F.Wpg_t = (bf16*)(ws + WS_WPG); F.Wpp_t = (bf16*)(ws + WS_WPP);
    F.BD = (float*)(ws + WS_BD); F.SSQ1 = (float*)(ws + WS_SSQ1); F.SSQ2 = (float*)(ws + WS_SSQ2); F.EGL = (float*)(ws + WS_EGL); F.X = (float*)(ws + WS_X);
    F.PB = (bf16*)(ws + WS_PB); F.RA = (bf16*)(ws + WS_RA); F.PROJ = (bf16*)(ws + WS_PROJ); F.HFF = (bf16*)(ws + WS_HFF); F.PP = (bf16*)(ws + WS_PP);
    F.MERGED = (bf16*)args.out; F.TA = (bf16*)((unsigned char*)args.out + 64 * MiB);
    F.DU = (bf16*)args.out; F.DNWK = (bf16*)((unsigned char*)args.out + 32 * MiB); F.DQG = (bf16*)((unsigned char*)args.out + 64 * MiB); F.DKDT = (bf16*)((unsigned char*)args.out + 96 * MiB); F.DPQK = (bf16*)(ws + WS_PQK);
    for (int u = F.tid; u < (LDS_BYTES - LDSCTL_OFF) / 4; u += NWAVES * 64) ((LAS unsigned*)(F.lds + LDSCTL_OFF))[u] = 0u;
    __syncthreads();
    const int bli = (N_LAUNCHES == PER_PHASE) ? 0 : args.li;
    XcdBarrier bar; bar.bar = (unsigned*)(F.ctl + CW_BAR) + bli * XCD_BAR_WORDS; bar.x = 0; bar.st = nullptr;
    if (N_LAUNCHES != PER_PHASE) bar = xcd_barrier_post((unsigned*)(F.ctl + CW_BAR) + bli * XCD_BAR_WORDS, F.MISC + 8);

    const int lo = args.ph_lo, hi = args.ph_hi;
#define IN(k) (lo <= (k) && (k) < hi)
#define BOTH(k) (IN(k) && IN((k) + 1))
    using namespace pg8;
#define REFRESH() do { F.lane = lane_id(); F.tid = F.wave * 64 + F.lane; } while (0)
    if (IN(0)) { REFRESH(); p0_prologue(F); if (BOTH(0)) GRID_BAR(0); }
    if (IN(1)) {
        { Gemm g{F.RA, F.Win_t, M, C_Z, DM, DM, DM}; StaticOrder S; S.init(M, C_Z, F.G, (int)blockIdx.x);
          EpiBf16 E{F.PROJ, NPROJ};
          gemm_phase<EpiBf16, StaticOrder, PG8_ALIGN, PG8_SP2>(F.lds + RING_OFF, g, S, E, F.wave); }
        { Gemm g{F.RA, F.Win_t + (size_t)C_Z * DM, M, 512, DM, DM, DM}; StaticOrder S; S.init(M, 512, F.G, (int)blockIdx.x);
          EpiGate E{F.PROJ + C_Z, NPROJ, F.w_onorm};
          gemm_phase<EpiGate, StaticOrder, PG8_ALIGN, PG8_SP2>(F.lds + RING_OFF, g, S, E, F.wave); }
        if (BOTH(1)) GRID_BAR(1);
    }
    if (IN(2)) { REFRESH(); dn_prep(F); if (BOTH(2)) GRID_BAR(2); }
    if (IN(3)) { REFRESH(); p3_mix(F); if (BOTH(3)) GRID_BAR(3); }
    if (IN(4)) {
        Gemm g{F.RA, F.Wa_t, M, DM, DM, DM, DM}; StaticOrder S; S.init(M, DM, F.G, (int)blockIdx.x);
        EpiMergeF E{F.PROJ + C_GA, F.PROJ + C_GB, NPROJ, F.MERGED};
        gemm_phase<EpiMergeF, StaticOrder, PG8_ALIGN, PG8_SP2>(F.lds + RING_OFF, g, S, E, F.wave);
        late_weights_q<0>(F);
        if (BOTH(4)) GRID_BAR(4);
    }
    if (IN(6)) {
        Gemm g{F.MERGED, F.Wo_t, M, DM, DM, DM, DM}; StaticOrder S; S.init(M, DM, F.G, (int)blockIdx.x);
        EpiRes<false> E{F.x, nullptr, F.RA, F.SSQ1};
        gemm_phase<EpiRes<false>, StaticOrder, PG8_ALIGN, PG8_SP2>(F.lds + RING_OFF, g, S, E, F.wave);
        late_weights_q<1>(F);
        if (BOTH(6)) GRID_BAR(6);
    }
    if (IN(7)) {
        Gemm g{F.RA, F.Wgu_t, M, 2 * DFF, DM, DM, DM}; StaticOrder S; S.init(M, 2 * DFF, F.G, (int)blockIdx.x);
        LAS float* rtab = (LAS float*)(F.lds + 131072);
        { REFRESH();
          for (int e = F.tid; e < 11 * 256; e += NWAVES * 64) { const int ui = e >> 8; Unit uu; if (S.next(ui, uu)) rtab[e] = rstd_from(F.SSQ1, uu.pm * 256 + (e & 255)); }
          __syncthreads(); }
        EpiSwiglu E{rtab, F.HFF, DFF};
        gemm_phase<EpiSwiglu, StaticOrder, PG8_ALIGN, PG8_SP2>(F.lds + RING_OFF, g, S, E, F.wave);
        late_weights_q<2>(F);
        if (BOTH(7)) GRID_BAR(7);
    }
    if (IN(8)) {
        Gemm g{F.HFF, F.Wdn_t, M, DM, DFF, DFF, DFF}; StaticOrder S; S.init(M, DM, F.G, (int)blockIdx.x);
        EpiRes<true> E{nullptr, F.RA, F.RA, F.SSQ2};
        gemm_phase<EpiRes<true>, StaticOrder, PG8_ALIGN, PG8_SP2>(F.lds + RING_OFF, g, S, E, F.wave);
        if (BOTH(8)) GRID_BAR(8);
    }
    if (IN(10)) {
        { Gemm g{F.PB, F.Wpp_t, M, DM, PLE, PLE, PLE}; StaticOrder S; S.init(M, DM, F.G, (int)blockIdx.x);
          EpiBf16 E{F.PP, DM};
          gemm_phase<EpiBf16, StaticOrder, PG8_ALIGN, PG8_SP2>(F.lds + RING_OFF, g, S, E, F.wave); }
        Gemm g{F.RA, F.Wpg_t, M, DM, DM, DM, DM}; StaticOrder S; S.init(M, DM, F.G, (int)blockIdx.x);
        EpiPleNorm E{F.SSQ2, F.RA, F.PP, F.out, (float*)(ws + WS_SSQ3), (unsigned*)(F.ctl + CW_PANEL), F.g_final};
        gemm_phase<EpiPleNorm, StaticOrder, PG8_ALIGN, PG8_SP2>(F.lds + RING_OFF, g, S, E, F.wave);
    }
#undef IN
#undef BOTH
}

extern "C" void kernel_launch(void* const* d_in, const int* in_sizes, int n_in, void* d_out, int out_size, void* d_ws, size_t ws_size, hipStream_t stream) {
    static int grid = 0;
    if (grid == 0) {
        if (n_in != 19 || in_sizes[0] != M * DM || out_size != M * DM || ws_size < WS_END) { fprintf(stderr, "kernel_launch: unexpected shapes: n_in %d in0 %d out %d ws %zu\n", n_in, n_in > 0 ? in_sizes[0] : -1, out_size, ws_size); grid = -1; return; }
        int dev = 0, cus = 0;
        if (hipGetDevice(&dev) != hipSuccess || hipDeviceGetAttribute(&cus, hipDeviceAttributeMultiprocessorCount, dev) != hipSuccess) { grid = -1; return; }
        if (hipFuncSetAttribute((const void*)mk_fwd, hipFuncAttributeMaxDynamicSharedMemorySize, LDS_BYTES) != hipSuccess) { fprintf(stderr, "kernel_launch: hipFuncSetAttribute failed\n"); grid = -1; return; }
        (void)hipGetLastError();
        grid = cus;
        if (grid != 256) fprintf(stderr, "kernel_launch: %d CUs (built for 256)\n", grid);
    }
    if (grid < 0) return;
    if (hipMemsetAsync((char*)d_ws + WS_CTL, 0, CTL_ZERO_BYTES, stream) != hipSuccess) return;
    Args a{};
    for (int i = 0; i < 19; ++i) a.in[i] = (const float*)d_in[i];
    a.out = (float*)d_out; a.ws = (unsigned char*)d_ws;
    for (int li = 0; li < N_LAUNCHES; ++li) {
        if (N_LAUNCHES == PER_PHASE) { a.ph_lo = li; a.ph_hi = li + 1; } else { a.ph_lo = 0; a.ph_hi = PER_PHASE; }
        a.li = li;
        hipLaunchKernelGGL(mk_fwd, dim3(grid), dim3(NWAVES * 64), LDS_BYTES, stream, a);
        const hipError_t le = hipPeekAtLastError();
        if (le != hipSuccess) { fprintf(stderr, "kernel_launch: launch %d failed: %s\n", li, hipGetErrorName(le)); break; }
    }
}
```

```cpp
#include <hip/hip_runtime.h>
#include <cstdio>
#include <cstdint>

#ifndef MK_N_LAUNCHES
#define MK_N_LAUNCHES 1
#endif

__device__ __forceinline__ int lane_id() { int l; asm volatile("v_mbcnt_lo_u32_b32 %0, -1, 0\n\tv_mbcnt_hi_u32_b32 %0, -1, %0" : "=v"(l)); return l; }
namespace pg8 {
#define PG8_LAS __attribute__((address_space(3)))
typedef unsigned short bf16_t;
typedef short bf16x8 __attribute__((ext_vector_type(8)));
typedef float f32x4 __attribute__((ext_vector_type(4)));
typedef unsigned u32x4 __attribute__((ext_vector_type(4)));
constexpr int BM = 256, BK = 64, HALF = 128, HTB = HALF * BK * 2, STAGE_BYTES = 8 * HTB, NXCD = 8, WGM = 8;

__host__ __device__ __forceinline__ int lds_byte(int r, int c) { const int st = (r >> 4) * 2 + (c >> 5), rr = r & 15, cc = c & 31, ob = rr * 64 + cc * 2; return st * 1024 + (ob ^ (((ob >> 9) & 1) << 5)); }
__host__ __device__ __forceinline__ void stage_rc(int b, int& R, int& C) { const int st = b / 1024, sb = b % 1024, swz = sb ^ (((sb >> 9) & 1) << 5); R = (st >> 1) * 16 + swz / 64; C = (st & 1) * 32 + (swz % 64) / 2; }
__host__ __device__ __forceinline__ int perm32(int rho) { const int n = rho >> 4, i = rho & 15; return 8 * (i >> 2) + 4 * n + (i & 3); }

struct Unit { int pm, pn, idx; };
struct Gemm { const bf16_t* A; const bf16_t* Bt; int M, N, K, lda, ldb; };

struct StaticOrder {
    int nM, nN, nwg, G, c;
    __host__ __device__ void init(int M, int N, int G_, int c_) { nM = M / BM; nN = N / BM; nwg = nM * nN; G = G_; c = c_; }
    __host__ __device__ bool next(int i, Unit& u) const {
        const long L = (long)i * G + c; if (L >= nwg) return false;
        int wgid = (int)L; { const int q = nwg / NXCD, r = nwg % NXCD, xcd = wgid % NXCD, off = wgid / NXCD; wgid = (xcd < r ? xcd * (q + 1) : r * (q + 1) + (xcd - r) * q) + off; }
        const int nig = WGM * nN, gid = wgid / nig, fm = gid * WGM, gsz = (nM - fm) < WGM ? (nM - fm) : WGM;
        u.pm = fm + ((wgid % nig) % gsz); u.pn = (wgid % nig) / gsz; u.idx = i; return true;
    }
    __device__ __forceinline__ void a_ready(const Unit&) const {}
    __device__ __forceinline__ void done(const Unit&) const {}
};

__device__ __forceinline__ unsigned cvt_pk_bf16(float lo, float hi) { unsigned r; asm volatile("v_cvt_pk_bf16_f32 %0, %1, %2" : "=v"(r) : "v"(lo), "v"(hi)); return r; }
__device__ __forceinline__ float bf_lo(unsigned u) { return __uint_as_float(u << 16); }
__device__ __forceinline__ float bf_hi(unsigned u) { return __uint_as_float(u & 0xffff0000u); }
__device__ __forceinline__ float sigm(float x) { return __builtin_amdgcn_rcpf(1.0f + __builtin_amdgcn_exp2f(-1.4426950408889634f * x)); }
__device__ __forceinline__ u32x4 pack8(const f32x4 a, const f32x4 b) { u32x4 w; w.x = cvt_pk_bf16(a[0], a[1]); w.y = cvt_pk_bf16(a[2], a[3]); w.z = cvt_pk_bf16(b[0], b[1]); w.w = cvt_pk_bf16(b[2], b[3]); return w; }
__device__ __forceinline__ void unpack8(const u32x4 w, f32x4& a, f32x4& b) { a = (f32x4){bf_lo(w.x), bf_hi(w.x), bf_lo(w.y), bf_hi(w.y)}; b = (f32x4){bf_lo(w.z), bf_hi(w.z), bf_lo(w.w), bf_hi(w.w)}; }
__device__ __forceinline__ float rstd_from(const float* ssq, int row) {
    const f32x4* p = (const f32x4*)(ssq + (size_t)row * 16);
    const f32x4 a = p[0], b = p[1], c = p[2], d = p[3];
    const float s = ((a[0] + a[1]) + (a[2] + a[3])) + ((b[0] + b[1]) + (b[2] + b[3])) + ((c[0] + c[1]) + (c[2] + c[3])) + ((d[0] + d[1]) + (d[2] + d[3]));
    return __builtin_amdgcn_rsqf(s * (1.0f / 1024.0f) + 1e-6f);
}

__device__ __forceinline__ float fq_sum(float v) {
    { const auto r = __builtin_amdgcn_permlane16_swap(__float_as_uint(v), __float_as_uint(v), false, false); v = __uint_as_float(r[0]) + __uint_as_float(r[1]); }
    { const auto r = __builtin_amdgcn_permlane32_swap(__float_as_uint(v), __float_as_uint(v), false, false); v = __uint_as_float(r[0]) + __uint_as_float(r[1]); }
    return v;
}
__device__ __forceinline__ void rstd8(const float* ssq, int row0, int fq, float (&r)[8]) {
    f32x4 p[8];
#pragma unroll
    for (int k = 0; k < 8; ++k) p[k] = *(const f32x4*)(ssq + (size_t)(row0 + (k >> 2) * HALF + (k & 3) * 16) * 16 + 4 * fq);
#pragma unroll
    for (int k = 0; k < 8; ++k) r[k] = __builtin_amdgcn_rsqf(fq_sum((p[k][0] + p[k][1]) + (p[k][2] + p[k][3])) * (1.0f / 1024.0f) + 1e-6f);
}
struct EpiBf16 {
    static constexpr bool PERM = true, AFTER_DRAIN = false, HAS_MID = false;
    bf16_t* O; int ldc;
    __device__ __forceinline__ void operator()(const f32x4 (&acc)[2][2][4][2], const Unit& u, int wr, int wc, int fr, int fq) const {
        const int row0 = u.pm * BM + wr * 64 + fr; const int col0 = u.pn * BM + wc * 32 + 8 * fq;
#pragma unroll
        for (int ai = 0; ai < 2; ++ai)
#pragma unroll
            for (int m = 0; m < 4; ++m) { bf16_t* rowp = O + (size_t)(row0 + ai * HALF + m * 16) * ldc + col0;
#pragma unroll
                for (int bj = 0; bj < 2; ++bj) *(u32x4*)(rowp + bj * HALF) = pack8(acc[ai][bj][m][0], acc[ai][bj][m][1]); }
    }
};
struct EpiGate {
    static constexpr bool PERM = true, AFTER_DRAIN = false, HAS_MID = false;
    bf16_t* O; int ldc; const float* wn;
    __device__ __forceinline__ void operator()(const f32x4 (&acc)[2][2][4][2], const Unit& u, int wr, int wc, int fr, int fq) const {
        const int row0 = u.pm * BM + wr * 64 + fr; const int col0 = u.pn * BM + wc * 32 + 8 * fq;
#pragma unroll
        for (int bj = 0; bj < 2; ++bj) { const f32x4 g0 = *(const f32x4*)(wn + ((col0 + bj * HALF) & 127)), g1 = *(const f32x4*)(wn + ((col0 + bj * HALF) & 127) + 4);
#pragma unroll
            for (int ai = 0; ai < 2; ++ai)
#pragma unroll
                for (int m = 0; m < 4; ++m) { f32x4 v0 = acc[ai][bj][m][0], v1 = acc[ai][bj][m][1];
#pragma unroll
                    for (int i = 0; i < 4; ++i) { v0[i] = v0[i] * sigm(v0[i]) * g0[i]; v1[i] = v1[i] * sigm(v1[i]) * g1[i]; }
                    *(u32x4*)(O + (size_t)(row0 + ai * HALF + m * 16) * ldc + col0 + bj * HALF) = pack8(v0, v1); } }
    }
};
struct EpiMergeF {
    static constexpr bool PERM = true, AFTER_DRAIN = false, HAS_MID = true;
    const bf16_t* ga; const bf16_t* gb; int ldg; bf16_t* OUT;
    __device__ __forceinline__ void mid(f32x4 (&acc)[2][2][4][2], const Unit& u, int wr, int wc, int fr, int fq) const {
        int opq = 0; asm volatile("" : "+v"(opq));
        const int row0 = u.pm * BM + wr * 64 + fr + opq; const int col0 = u.pn * BM + wc * 32 + 8 * fq;
#pragma unroll
        for (int ai = 0; ai < 2; ++ai) {
            u32x4 aw[4][2], bw[4][2];
#pragma unroll
            for (int m = 0; m < 4; ++m)
#pragma unroll
                for (int bj = 0; bj < 2; ++bj) { const size_t o = (size_t)(row0 + ai * HALF + m * 16) * ldg + col0 + bj * HALF; aw[m][bj] = *(const u32x4*)(ga + o); bw[m][bj] = *(const u32x4*)(gb + o); }
#pragma unroll
            for (int m = 0; m < 4; ++m)
#pragma unroll
                for (int bj = 0; bj < 2; ++bj) { f32x4 a0, a1, b0, b1; unpack8(aw[m][bj], a0, a1); unpack8(bw[m][bj], b0, b1);
#pragma unroll
                    for (int i = 0; i < 4; ++i) {
                        acc[ai][bj][m][0][i] *= (1.0f + __builtin_amdgcn_exp2f(-1.4426950408889634f * b0[i])) * __builtin_amdgcn_rcpf(1.0f + __builtin_amdgcn_exp2f(-1.4426950408889634f * a0[i]));
                        acc[ai][bj][m][1][i] *= (1.0f + __builtin_amdgcn_exp2f(-1.4426950408889634f * b1[i])) * __builtin_amdgcn_rcpf(1.0f + __builtin_amdgcn_exp2f(-1.4426950408889634f * a1[i])); } }
        }
    }
    __device__ __forceinline__ void operator()(const f32x4 (&acc)[2][2][4][2], const Unit& u, int wr, int wc, int fr, int fq) const {
        const int row0 = u.pm * BM + wr * 64 + fr; const int col0 = u.pn * BM + wc * 32 + 8 * fq;
        u32x4 bw[2][4][2];
#pragma unroll
        for (int ai = 0; ai < 2; ++ai)
#pragma unroll
            for (int m = 0; m < 4; ++m)
#pragma unroll
                for (int bj = 0; bj < 2; ++bj) bw[ai][m][bj] = *(const u32x4*)(gb + (size_t)(row0 + ai * HALF + m * 16) * ldg + col0 + bj * HALF);
#pragma unroll
        for (int ai = 0; ai < 2; ++ai)
#pragma unroll
            for (int m = 0; m < 4; ++m)
#pragma unroll
                for (int bj = 0; bj < 2; ++bj) { f32x4 b0, b1; unpack8(bw[ai][m][bj], b0, b1); f32x4 v0 = acc[ai][bj][m][0], v1 = acc[ai][bj][m][1];
#pragma unroll
                    for (int i = 0; i < 4; ++i) { v0[i] *= sigm(b0[i]); v1[i] *= sigm(b1[i]); }
                    bw[ai][m][bj] = pack8(v0, v1); }
#pragma unroll
        for (int ai = 0; ai < 2; ++ai)
#pragma unroll
            for (int m = 0; m < 4; ++m)
#pragma unroll
                for (int bj = 0; bj < 2; ++bj) *(u32x4*)(OUT + (size_t)(row0 + ai * HALF + m * 16) * 1024 + col0 + bj * HALF) = bw[ai][m][bj];
    }
};
template <bool BASE_BF16> struct EpiRes {
    static constexpr bool PERM = true, AFTER_DRAIN = false, HAS_MID = false;
    const float* base; const bf16_t* baseb; bf16_t* outb; float* ssq;
    __device__ __forceinline__ void operator()(const f32x4 (&acc)[2][2][4][2], const Unit& u, int wr, int wc, int fr, int fq) const {
        const int row0 = u.pm * BM + wr * 64 + fr; const int col0 = u.pn * BM + wc * 32 + 8 * fq;
        if constexpr (BASE_BF16) {
            u32x4 w[2][4][2]; float ss[8];
#pragma unroll
            for (int ai = 0; ai < 2; ++ai)
#pragma unroll
                for (int m = 0; m < 4; ++m)
#pragma unroll
                    for (int bj = 0; bj < 2; ++bj) w[ai][m][bj] = *(const u32x4*)(baseb + (size_t)(row0 + ai * HALF + m * 16) * 1024 + col0 + bj * HALF);
#pragma unroll
            for (int ai = 0; ai < 2; ++ai)
#pragma unroll
                for (int m = 0; m < 4; ++m) { float s = 0.f;
#pragma unroll
                    for (int bj = 0; bj < 2; ++bj) { f32x4 v0, v1; unpack8(w[ai][m][bj], v0, v1); v0 += acc[ai][bj][m][0]; v1 += acc[ai][bj][m][1]; w[ai][m][bj] = pack8(v0, v1);
                        s += (v0[0] * v0[0] + v0[1] * v0[1]) + (v0[2] * v0[2] + v0[3] * v0[3]) + (v1[0] * v1[0] + v1[1] * v1[1]) + (v1[2] * v1[2] + v1[3] * v1[3]); }
                    ss[ai * 4 + m] = fq_sum(s); }
#pragma unroll
            for (int ai = 0; ai < 2; ++ai)
#pragma unroll
                for (int m = 0; m < 4; ++m) { const size_t row = (size_t)(row0 + ai * HALF + m * 16);
#pragma unroll
                    for (int bj = 0; bj < 2; ++bj) *(u32x4*)(outb + row * 1024 + col0 + bj * HALF) = w[ai][m][bj];
                    if (fq == 0) ssq[row * 16 + u.pn * 4 + wc] = ss[ai * 4 + m]; }
        } else {
#pragma unroll
            for (int ai = 0; ai < 2; ++ai) {
                f32x4 b[4][2][2]; u32x4 w[4][2]; float ss[4];
#pragma unroll
                for (int m = 0; m < 4; ++m)
#pragma unroll
                    for (int bj = 0; bj < 2; ++bj) { const float* p = base + (size_t)(row0 + ai * HALF + m * 16) * 1024 + col0 + bj * HALF; b[m][bj][0] = __builtin_nontemporal_load((const f32x4*)p); b[m][bj][1] = __builtin_nontemporal_load((const f32x4*)(p + 4)); }
#pragma unroll
                for (int m = 0; m < 4; ++m) { float s = 0.f;
#pragma unroll
                    for (int bj = 0; bj < 2; ++bj) { const f32x4 v0 = b[m][bj][0] + acc[ai][bj][m][0], v1 = b[m][bj][1] + acc[ai][bj][m][1]; w[m][bj] = pack8(v0, v1);
                        s += (v0[0] * v0[0] + v0[1] * v0[1]) + (v0[2] * v0[2] + v0[3] * v0[3]) + (v1[0] * v1[0] + v1[1] * v1[1]) + (v1[2] * v1[2] + v1[3] * v1[3]); }
                    ss[m] = fq_sum(s); }
#pragma unroll
                for (int m = 0; m < 4; ++m) { const size_t row = (size_t)(row0 + ai * HALF + m * 16);
#pragma unroll
                    for (int bj = 0; bj < 2; ++bj) *(u32x4*)(outb + row * 1024 + col0 + bj * HALF) = w[m][bj];
                    if (fq == 0) ssq[row * 16 + u.pn * 4 + wc] = ss[m]; }
            }
        }
    }
};
struct EpiSwiglu {
    static constexpr bool PERM = true, AFTER_DRAIN = false, HAS_MID = false;
    const PG8_LAS float* rtab; bf16_t* H; int ldh;
    __device__ __forceinline__ void operator()(const f32x4 (&acc)[2][2][4][2], const Unit& u, int wr, int wc, int fr, int fq) const {
        const int row0 = u.pm * BM + wr * 64 + fr; const int col0 = u.pn * HALF + wc * 32 + 8 * fq;
        float r[8];
#pragma unroll
        for (int k = 0; k < 8; ++k) r[k] = rtab[u.idx * 256 + wr * 64 + fr + (k >> 2) * HALF + (k & 3) * 16];
        u32x4 w[8];
#pragma unroll
        for (int k = 0; k < 8; ++k) { const int ai = k >> 2, m = k & 3; f32x4 h0, h1;
#pragma unroll
            for (int i = 0; i < 4; ++i) { const float g0 = acc[ai][0][m][0][i] * r[k], g1 = acc[ai][0][m][1][i] * r[k];
                h0[i] = g0 * sigm(g0) * (acc[ai][1][m][0][i] * r[k]); h1[i] = g1 * sigm(g1) * (acc[ai][1][m][1][i] * r[k]); }
            w[k] = pack8(h0, h1); }
#pragma unroll
        for (int k = 0; k < 8; ++k) *(u32x4*)(H + (size_t)(row0 + (k >> 2) * HALF + (k & 3) * 16) * ldh + col0) = w[k];
    }
};
struct EpiPle {
    static constexpr bool PERM = true, AFTER_DRAIN = false, HAS_MID = false;
    const float* ssq; const bf16_t* base; const bf16_t* PP; bf16_t* out;
    __device__ __forceinline__ void operator()(const f32x4 (&acc)[2][2][4][2], const Unit& u, int wr, int wc, int fr, int fq) const {
        const int row0 = u.pm * BM + wr * 64 + fr; const int col0 = u.pn * BM + wc * 32 + 8 * fq;
#pragma unroll
        for (int ai = 0; ai < 2; ++ai)
#pragma unroll
            for (int m = 0; m < 4; ++m) { const int row = row0 + ai * HALF + m * 16; const float r = rstd_from(ssq, row);
#pragma unroll
                for (int bj = 0; bj < 2; ++bj) { const size_t off = (size_t)row * 1024 + col0 + bj * HALF;
                    const u32x4 pw = *(const u32x4*)(PP + off); f32x4 p0, p1; unpack8(pw, p0, p1);
                    const u32x4 bw = *(const u32x4*)(base + off); f32x4 v0, v1; unpack8(bw, v0, v1);
#pragma unroll
                    for (int i = 0; i < 4; ++i) { v0[i] += sigm(acc[ai][bj][m][0][i] * r) * p0[i]; v1[i] += sigm(acc[ai][bj][m][1][i] * r) * p1[i]; }
                    *(u32x4*)(out + off) = pack8(v0, v1); } }
    }
};

struct EpiPleNorm {
    static constexpr bool PERM = true, AFTER_DRAIN = false, HAS_MID = false;
    const float* ssq2; const bf16_t* base; const bf16_t* PP; float* out; float* ssq3; unsigned* cnt; const float* gfin;
    __device__ __forceinline__ void operator()(f32x4 (&acc)[2][2][4][2], const Unit& u, int wr, int wc, int fr, int fq) const {
        const int row0 = u.pm * BM + wr * 64 + fr; const int col0 = u.pn * BM + wc * 32 + 8 * fq;
        float r2[8], ss[8];
        u32x4 pw[4][2], bw[4][2];
        {
            f32x4 pr[8];
#pragma unroll
            for (int k = 0; k < 8; ++k) pr[k] = *(const f32x4*)(ssq2 + (size_t)(row0 + (k >> 2) * HALF + (k & 3) * 16) * 16 + 4 * fq);
#pragma unroll
            for (int m = 0; m < 4; ++m)
#pragma unroll
                for (int bj = 0; bj < 2; ++bj) { const size_t off = (size_t)(row0 + m * 16) * 1024 + col0 + bj * HALF; pw[m][bj] = *(const u32x4*)(PP + off); bw[m][bj] = *(const u32x4*)(base + off); }
#pragma unroll
            for (int k = 0; k < 8; ++k) r2[k] = __builtin_amdgcn_rsqf(fq_sum((pr[k][0] + pr[k][1]) + (pr[k][2] + pr[k][3])) * (1.0f / 1024.0f) + 1e-6f);
        }
#pragma unroll
        for (int ai = 0; ai < 2; ++ai) {
            if (ai == 1) {
#pragma unroll
                for (int m = 0; m < 4; ++m)
#pragma unroll
                    for (int bj = 0; bj < 2; ++bj) { const size_t off = (size_t)(row0 + HALF + m * 16) * 1024 + col0 + bj * HALF; pw[m][bj] = *(const u32x4*)(PP + off); bw[m][bj] = *(const u32x4*)(base + off); } }
#pragma unroll
            for (int m = 0; m < 4; ++m) { const float r = r2[ai * 4 + m]; float s = 0.f;
#pragma unroll
                for (int bj = 0; bj < 2; ++bj) { f32x4 p0, p1, v0, v1; unpack8(pw[m][bj], p0, p1); unpack8(bw[m][bj], v0, v1);
#pragma unroll
                    for (int i = 0; i < 4; ++i) { v0[i] += sigm(acc[ai][bj][m][0][i] * r) * p0[i]; v1[i] += sigm(acc[ai][bj][m][1][i] * r) * p1[i]; }
                    acc[ai][bj][m][0] = v0; acc[ai][bj][m][1] = v1;
                    s += (v0[0] * v0[0] + v0[1] * v0[1]) + (v0[2] * v0[2] + v0[3] * v0[3]) + (v1[0] * v1[0] + v1[1] * v1[1]) + (v1[2] * v1[2] + v1[3] * v1[3]); }
                ss[ai * 4 + m] = fq_sum(s); }
        }
        if (fq == 0) {
#pragma unroll
            for (int k = 0; k < 8; ++k) __hip_atomic_store(ssq3 + (size_t)(row0 + (k >> 2) * HALF + (k & 3) * 16) * 16 + u.pn * 4 + wc, ss[k], __ATOMIC_RELAXED, __HIP_MEMORY_SCOPE_AGENT); }
        asm volatile("s_waitcnt vmcnt(0)" ::: "memory");
        __builtin_amdgcn_s_barrier(); asm volatile("" ::: "memory");
        if (wr == 0 && wc == 0) {
            unsigned* c = cnt + 64 * u.pm;
            if (lane_id() == 0) __hip_atomic_fetch_add(c, 1u, __ATOMIC_RELAXED, __HIP_MEMORY_SCOPE_AGENT);
            unsigned sp = 0;
            while ((unsigned)__builtin_amdgcn_readfirstlane(__hip_atomic_load(c, __ATOMIC_RELAXED, __HIP_MEMORY_SCOPE_AGENT)) < 4u) { __builtin_amdgcn_s_sleep(2); if (++sp > (1u << 20)) break; }
            __builtin_amdgcn_fence(__ATOMIC_ACQUIRE, "agent");
            asm volatile("s_waitcnt vmcnt(0)" ::: "memory");
        }
        __builtin_amdgcn_s_barrier(); asm volatile("" ::: "memory");
        f32x4 g0[2], g1[2];
#pragma unroll
        for (int bj = 0; bj < 2; ++bj) { g0[bj] = *(const f32x4*)(gfin + col0 + bj * HALF); g1[bj] = *(const f32x4*)(gfin + col0 + bj * HALF + 4); }
        int opq = 0; asm volatile("" : "+v"(opq)); const int row1 = row0 + opq;
        float r3[8]; rstd8(ssq3, row1, fq, r3);
#pragma unroll
        for (int ai = 0; ai < 2; ++ai)
#pragma unroll
            for (int m = 0; m < 4; ++m) { const size_t row = (size_t)(row1 + ai * HALF + m * 16); const float r = r3[ai * 4 + m];
#pragma unroll
                for (int bj = 0; bj < 2; ++bj) { const size_t off = row * 1024 + col0 + bj * HALF;
                    *(f32x4*)(out + off) = acc[ai][bj][m][0] * r * g0[bj]; *(f32x4*)(out + off + 4) = acc[ai][bj][m][1] * r * g1[bj]; } }
    }
};

template <class Epi, class Sched, bool ALIGN_EPI = false, bool SP2 = false>
__device__ __forceinline__ void gemm_phase(PG8_LAS unsigned char* lds, const Gemm g, const Sched& S, const Epi& E, int wid) {
    const int lane = lane_id(), tid = wid * 64 + lane, wr = wid >> 2, wc = wid & 3, fr = lane & 15, fq = lane >> 4;
    const int K = g.K, nt = K / BK;
    unsigned voffA[2], voffB[2];
#pragma unroll
    for (int i = 0; i < 2; ++i) { int R, C; stage_rc(tid * 16 + i * 8192, R, C); const int Rb = Epi::PERM ? ((R & ~31) + perm32(R & 31)) : R;
        voffA[i] = (unsigned)(R * g.lda + C) * 2u; voffB[i] = (unsigned)(Rb * g.ldb + C) * 2u; }
    const size_t kstep = (size_t)(BK * 2);
    const size_t hstepA = (size_t)HALF * g.lda * 2, hstepB = (size_t)HALF * g.ldb * 2;
    const size_t tstepA = 2 * hstepA, tstepB = 2 * hstepB;
    const unsigned ldsw = (unsigned)wid * 1024u;
    const int aoff = lds_byte(wr * 64 + fr, fq * 8), boff = lds_byte(wc * 32 + fr, fq * 8);
#define PG8_SA(b, h) (((b) * 2 + (h)) * HTB)
#define PG8_SB(b, h) ((4 + (b) * 2 + (h)) * HTB)
#define PG8_STAGE(bufoff, gbase, voff) do { _Pragma("unroll") for (int _i = 0; _i < 2; ++_i) \
        __builtin_amdgcn_global_load_lds((const unsigned*)((const char*)(gbase) + (voff)[_i]), (PG8_LAS unsigned*)(lds + (bufoff) + ldsw + _i * 8192), 16, 0, 0); } while (0)
#define PG8_LDA(dst, b, h) do { _Pragma("unroll") for (int m = 0; m < 4; ++m) _Pragma("unroll") for (int k = 0; k < 2; ++k) dst[m][k] = *(const PG8_LAS bf16x8*)(lds + PG8_SA(b, h) + aoff + m * 2048 + k * 1024); } while (0)
#define PG8_LDB(dst, b, h) do { _Pragma("unroll") for (int n = 0; n < 2; ++n) _Pragma("unroll") for (int k = 0; k < 2; ++k) dst[n][k] = *(const PG8_LAS bf16x8*)(lds + PG8_SB(b, h) + boff + n * 2048 + k * 1024); } while (0)
#define PG8_MMA(ai, bj, At, Bt) do { __builtin_amdgcn_s_setprio(1); _Pragma("unroll") for (int m = 0; m < 4; ++m) _Pragma("unroll") for (int n = 0; n < 2; ++n) _Pragma("unroll") for (int k = 0; k < 2; ++k) \
        acc[ai][bj][m][n] = __builtin_amdgcn_mfma_f32_16x16x32_bf16(Bt[n][k], At[m][k], acc[ai][bj][m][n], 0, 0, 0); __builtin_amdgcn_s_setprio(0); } while (0)
#define PG8_WAIT_V(n) asm volatile("s_waitcnt vmcnt(" #n ")" ::: "memory")
#define PG8_WAIT_L(n) asm volatile("s_waitcnt lgkmcnt(" #n ")" ::: "memory")
#define PG8_BAR __builtin_amdgcn_s_barrier()
#define PG8_SCHED __builtin_amdgcn_sched_barrier(0)
    Unit cur, nxt; int ui = 0;
    if (!S.next(0, cur)) return;
    f32x4 acc[2][2][4][2];
#pragma unroll
    for (int a = 0; a < 2; ++a)
#pragma unroll
        for (int b = 0; b < 2; ++b)
#pragma unroll
            for (int m = 0; m < 4; ++m)
#pragma unroll
                for (int n = 0; n < 2; ++n) acc[a][b][m][n] = (f32x4){0.f, 0.f, 0.f, 0.f};
    bf16x8 At[4][2], B0[2][2], B1[2][2];
    const char* cA = (const char*)g.A + (size_t)cur.pm * tstepA; const char* cB = (const char*)g.Bt + (size_t)cur.pn * tstepB;
    S.a_ready(cur);
    if constexpr (SP2) {
        PG8_STAGE(PG8_SB(0, 0), cB, voffB); PG8_STAGE(PG8_SB(0, 1), cB + hstepB, voffB); PG8_STAGE(PG8_SA(0, 0), cA, voffA); PG8_STAGE(PG8_SA(0, 1), cA + hstepA, voffA);
        if (wr == 1) PG8_BAR;
        PG8_WAIT_V(2); PG8_BAR;
        PG8_STAGE(PG8_SB(1, 0), cB + kstep, voffB); PG8_STAGE(PG8_SA(1, 0), cA + kstep, voffA); PG8_STAGE(PG8_SB(1, 1), cB + hstepB + kstep, voffB);
        PG8_WAIT_V(6); PG8_BAR;
    } else {
        PG8_STAGE(PG8_SB(0, 0), cB, voffB); PG8_STAGE(PG8_SA(0, 0), cA, voffA); PG8_STAGE(PG8_SB(0, 1), cB + hstepB, voffB); PG8_STAGE(PG8_SA(0, 1), cA + hstepA, voffA);
        if (wr == 1) PG8_BAR;
        PG8_WAIT_V(4); PG8_BAR;
        PG8_STAGE(PG8_SB(1, 0), cB + kstep, voffB); PG8_STAGE(PG8_SA(1, 0), cA + kstep, voffA); PG8_STAGE(PG8_SB(1, 1), cB + hstepB + kstep, voffB);
        PG8_WAIT_V(6); PG8_BAR;
    }
    for (;;) {
        const bool has_next = S.next(ui + 1, nxt);
        const char* nA = has_next ? (const char*)g.A + (size_t)nxt.pm * tstepA : cA; const char* nB = has_next ? (const char*)g.Bt + (size_t)nxt.pn * tstepB : cB;
        for (int t = 0; t < nt; t += 2) {
            const bool last = (t == nt - 2);
            const char* a1 = cA + (size_t)(t + 1) * kstep;
            const char* a2 = last ? nA : cA + (size_t)(t + 2) * kstep; const char* b2 = last ? nB : cB + (size_t)(t + 2) * kstep;
            const char* a3 = a2 + kstep; const char* b3 = b2 + kstep;
            if (last && has_next) S.a_ready(nxt);
            if constexpr (Epi::HAS_MID) { if (t == nt / 2) E.mid(acc, cur, wr, wc, fr, fq); }
            if constexpr (SP2) {
            PG8_LDB(B0, 0, 0); PG8_LDB(B1, 0, 1); PG8_SCHED; PG8_LDA(At, 0, 0); PG8_STAGE(PG8_SA(1, 1), a1 + hstepA, voffA);
            PG8_WAIT_V(8); PG8_WAIT_L(0); PG8_BAR; PG8_MMA(0, 0, At, B0); PG8_MMA(0, 1, At, B1); PG8_BAR; PG8_SCHED;
            PG8_LDA(At, 0, 1); PG8_STAGE(PG8_SB(0, 0), b2, voffB); PG8_STAGE(PG8_SB(0, 1), b2 + hstepB, voffB); PG8_STAGE(PG8_SA(0, 0), a2, voffA);
            PG8_WAIT_V(8); PG8_WAIT_L(0); PG8_BAR; PG8_MMA(1, 0, At, B0); PG8_MMA(1, 1, At, B1); PG8_BAR; PG8_SCHED;
            PG8_LDB(B0, 1, 0); PG8_LDB(B1, 1, 1); PG8_SCHED; PG8_LDA(At, 1, 0); PG8_STAGE(PG8_SA(0, 1), a2 + hstepA, voffA);
            PG8_WAIT_V(8); PG8_WAIT_L(0); PG8_BAR; PG8_MMA(0, 0, At, B0); PG8_MMA(0, 1, At, B1); PG8_BAR; PG8_SCHED;
            PG8_LDA(At, 1, 1); PG8_STAGE(PG8_SB(1, 0), b3, voffB); PG8_STAGE(PG8_SB(1, 1), b3 + hstepB, voffB); PG8_STAGE(PG8_SA(1, 0), a3, voffA);
            PG8_WAIT_V(8); PG8_WAIT_L(0); PG8_BAR; PG8_MMA(1, 0, At, B0); PG8_MMA(1, 1, At, B1); PG8_BAR; PG8_SCHED;
            } else {
            PG8_LDB(B0, 0, 0); PG8_SCHED; PG8_LDA(At, 0, 0); PG8_STAGE(PG8_SA(1, 1), a1 + hstepA, voffA);
            PG8_WAIT_L(8); PG8_BAR; PG8_WAIT_L(0); PG8_MMA(0, 0, At, B0); PG8_BAR; PG8_SCHED;
            PG8_LDB(B1, 0, 1); PG8_STAGE(PG8_SB(0, 0), b2, voffB);
            PG8_BAR; PG8_WAIT_L(0); PG8_MMA(0, 1, At, B1); PG8_BAR;
            PG8_LDA(At, 0, 1); PG8_STAGE(PG8_SA(0, 0), a2, voffA);
            PG8_BAR; PG8_WAIT_L(0); PG8_MMA(1, 0, At, B0); PG8_BAR; PG8_SCHED;
            PG8_STAGE(PG8_SB(0, 1), b2 + hstepB, voffB);
            PG8_WAIT_V(6); PG8_BAR; PG8_MMA(1, 1, At, B1); PG8_BAR;
            PG8_LDB(B0, 1, 0); PG8_SCHED; PG8_LDA(At, 1, 0); PG8_STAGE(PG8_SA(0, 1), a2 + hstepA, voffA);
            PG8_WAIT_L(8); PG8_BAR; PG8_WAIT_L(0); PG8_MMA(0, 0, At, B0); PG8_BAR; PG8_SCHED;
            PG8_LDB(B1, 1, 1); PG8_STAGE(PG8_SB(1, 0), b3, voffB);
            PG8_BAR; PG8_WAIT_L(0); PG8_MMA(0, 1, At, B1); PG8_BAR;
            PG8_LDA(At, 1, 1); PG8_STAGE(PG8_SA(1, 0), a3, voffA);
            PG8_BAR; PG8_WAIT_L(0); PG8_MMA(1, 0, At, B0); PG8_BAR; PG8_SCHED;
            PG8_STAGE(PG8_SB(1, 1), b3 + hstepB, voffB);
            PG8_WAIT_V(6); PG8_BAR; PG8_MMA(1, 1, At, B1); PG8_BAR;
            }
        }
        if constexpr (ALIGN_EPI) { if (wr == 0) PG8_BAR; }
        if constexpr (!Epi::AFTER_DRAIN) { E(acc, cur, wr, wc, fr, fq); S.done(cur); }
        if (!has_next) break;
#pragma unroll
        for (int a = 0; a < 2; ++a)
#pragma unroll
            for (int b = 0; b < 2; ++b)
#pragma unroll
                for (int m = 0; m < 4; ++m)
#pragma unroll
                    for (int n = 0; n < 2; ++n) acc[a][b][m][n] = (f32x4){0.f, 0.f, 0.f, 0.f};
        cur = nxt; cA = nA; cB = nB; ++ui;
        if constexpr (ALIGN_EPI) { if (wr == 1) PG8_BAR; }
    }
    PG8_WAIT_V(0);
    if constexpr (!ALIGN_EPI) { if (wr == 0) PG8_BAR; }
    PG8_BAR;
#undef PG8_SA
#undef PG8_SB
#undef PG8_STAGE
#undef PG8_LDA
#undef PG8_LDB
#undef PG8_MMA
#undef PG8_WAIT_V
#undef PG8_WAIT_L
#undef PG8_BAR
#undef PG8_SCHED
}
}

#ifndef PG8_SP2
#define PG8_SP2 true
#endif
#ifndef PG8_ALIGN
#define PG8_ALIGN true
#endif

constexpr int NWAVES = 8;
constexpr int N_LAUNCHES = MK_N_LAUNCHES;
constexpr int PER_PHASE = 12;
constexpr int DM = 1024, BATCH = 16, SEQ = 2048, M = BATCH * SEQ, CHK = 64;
constexpr int DIN = 5640, NPROJ = 5632, DFF = 2816, PLE = 256;
constexpr int C_QA = 0, C_KA = 512, C_VA = 1024, C_CONV = 1536, C_GA = 3072, C_GB = 4096, C_Z = 5120;
constexpr int NREL = 257;
constexpr float EPS = 1e-6f;

constexpr size_t MiB = 1u << 20;
constexpr size_t WS_CTL = 0, CTL_ZERO_BYTES = 128 * 1024;
constexpr size_t WS_WIN = 1 * MiB;
constexpr size_t WS_WA = 12 * MiB, WS_WB = 13 * MiB;
constexpr size_t WS_WO = 14 * MiB;
constexpr size_t WS_WGU = 16 * MiB;
constexpr size_t WS_WDN = 27 * MiB;
constexpr size_t WS_WPG = 33 * MiB;
constexpr size_t WS_WPP = 35 * MiB;
constexpr size_t WS_BD = 36 * MiB;
constexpr size_t WS_PB = 37 * MiB;
constexpr size_t WS_SSQ1 = 53 * MiB, WS_SSQ2 = 55 * MiB;
constexpr size_t WS_SSQ3 = 60 * MiB;
constexpr size_t WS_EGL = 57 * MiB;
constexpr size_t WS_PQK = 480 * MiB;
constexpr int CW_ATTQ = 2048;
constexpr int CW_LATEQ = 3072;
constexpr int CW_PANEL = 16384;
constexpr size_t WS_RA = 64 * MiB;
constexpr size_t WS_PROJ = 128 * MiB;
constexpr size_t WS_X = 128 * MiB, WS_HFF = 256 * MiB, WS_PP = 432 * MiB;
constexpr size_t WS_END = 512 * MiB;
constexpr int CW_TMO = 0, CW_CODE = 1, CW_BAR = 4096;

constexpr int RING_OFF = 0, RING_BYTES = 147456;
constexpr int LDSCTL_OFF = RING_BYTES, MISC_OFF = LDSCTL_OFF + 320;
constexpr int LDS_BYTES = 149504;

#define GAS __attribute__((address_space(1)))
#define LAS __attribute__((address_space(3)))
typedef unsigned short bf16;
typedef unsigned v4u __attribute__((ext_vector_type(4)));
typedef float f32x4 __attribute__((ext_vector_type(4)));
typedef GAS unsigned gu32;
#define RLX_AGENT __ATOMIC_RELAXED, __HIP_MEMORY_SCOPE_AGENT
#define LDS_WAIT() asm volatile("s_waitcnt lgkmcnt(0)" ::: "memory")
#define VM_WAIT() asm volatile("s_waitcnt vmcnt(0)" ::: "memory")
__device__ __forceinline__ unsigned f2bf(float f) { unsigned u = __builtin_bit_cast(unsigned, f); return (u + 0x7fffu + ((u >> 16) & 1u)) >> 16; }
__device__ __forceinline__ unsigned pk2(float lo, float hi) { return f2bf(lo) | (f2bf(hi) << 16); }
__device__ __forceinline__ float bflo(unsigned u) { return __uint_as_float(u << 16); }
__device__ __forceinline__ float bfhi(unsigned u) { return __uint_as_float(u & 0xffff0000u); }
__device__ __forceinline__ float bf1(bf16 h) { return __uint_as_float(((unsigned)h) << 16); }
__device__ __forceinline__ void glds16(const void* gsrc, unsigned lds_dst) { unsigned keep;
    asm volatile("s_mov_b32 %0, m0\n\ts_mov_b32 m0, %2\n\ts_nop 0\n\tglobal_load_lds_dwordx4 %1, off\n\ts_mov_b32 m0, %0" : "=&s"(keep) : "v"(gsrc), "s"(lds_dst) : "memory"); }
#define LDS_ADDR(p) ((unsigned)(unsigned long)(p))

#define XB_TMO      128
#define XB_XCNT(j)  (256  + 64 * (j))
#define XB_XSUB(j)  (1280 + 64 * (j))
#define XB_XGEN(j)  (2304 + 64 * (j))
#define XB_TOP      3328
#define XB_TOPGEN   3392
#define XCD_BAR_WORDS 3456
#define XB_SPIN_CAP (1u << 18)
__device__ __forceinline__ unsigned xb_ld(unsigned* p)              { return __hip_atomic_load(p, __ATOMIC_RELAXED, __HIP_MEMORY_SCOPE_AGENT); }
__device__ __forceinline__ unsigned xb_add(unsigned* p, unsigned v) { return __hip_atomic_fetch_add(p, v, __ATOMIC_RELAXED, __HIP_MEMORY_SCOPE_AGENT); }
__device__ __forceinline__ unsigned xb_xcc_id() { return (unsigned)__builtin_amdgcn_s_getreg((3 << 11) | 20) & 0xFu; }
#define XB_SPIN(cond, bar) do { unsigned _sp = 0; while (cond) { __builtin_amdgcn_s_sleep(1); \
    if ((++_sp & 255u) == 0u) { if (xb_ld(&(bar)[XB_TMO])) break; if (_sp > XB_SPIN_CAP) { atomicAdd(&(bar)[XB_TMO], 1u); break; } } } } while (0)
struct XcdBarrier { unsigned* bar; unsigned x; volatile LAS unsigned* st; };
__device__ __forceinline__ XcdBarrier xcd_barrier_post(unsigned* bar, volatile LAS unsigned* st) {
    XcdBarrier b; b.bar = bar; b.x = xb_xcc_id(); b.st = st;
    if (threadIdx.x == 0) (void)xb_add(&bar[XB_XCNT(b.x)], 1u);
    return b;
}
__device__ __forceinline__ void xcd_barrier_complete(unsigned* bar, unsigned x, unsigned& nloc, unsigned& nx) {
    const unsigned G = gridDim.x * gridDim.y * gridDim.z;
    unsigned sum, cnt, mine, sp = 0u;
    for (;;) {
        sum = 0u; cnt = 0u; mine = 0u;
#pragma unroll
        for (unsigned j = 0; j < 16; ++j) { const unsigned c = xb_ld(&bar[XB_XCNT(j)]); sum += c; cnt += (c > 0u) ? 1u : 0u; mine = (j == x) ? c : mine; }
        if (sum == G) break;
        __builtin_amdgcn_s_sleep(1);
        if ((++sp & 255u) == 0u) { if (xb_ld(&bar[XB_TMO])) break; if (sp > XB_SPIN_CAP) { atomicAdd(&bar[XB_TMO], 1u); break; } }
    }
    nloc = mine > 0u ? mine : 1u; nx = cnt > 0u ? cnt : 1u;
}
__device__ __forceinline__ void xcd_barrier(const XcdBarrier& b) {
    asm volatile("s_waitcnt vmcnt(0)" ::: "memory");
    __syncthreads();
    if (threadIdx.x == 0) {
        unsigned* bar = b.bar;
        __builtin_amdgcn_s_waitcnt(0);
        unsigned nloc = b.st[0], nx = b.st[1];
        if (nloc == 0u) { xcd_barrier_complete(bar, b.x, nloc, nx); b.st[0] = nloc; b.st[1] = nx; }
        const unsigned old = xb_add(&bar[XB_XSUB(b.x)], 1u);
        const unsigned gen = old / nloc;
        if (old + 1u == (gen + 1u) * nloc) {
            __builtin_amdgcn_fence(__ATOMIC_RELEASE, "agent");
            asm volatile("s_waitcnt vmcnt(0)" ::: "memory");
            const unsigned og = xb_add(&bar[XB_TOP], 1u);
            const unsigned tg = og / nx;
            if (og + 1u == (tg + 1u) * nx) xb_add(&bar[XB_TOPGEN], 1u);
            else XB_SPIN(xb_ld(&bar[XB_TOPGEN]) == tg, bar);
            __builtin_amdgcn_fence(__ATOMIC_ACQUIRE, "agent");
            xb_add(&bar[XB_XGEN(b.x)], 1u);
            asm volatile("s_waitcnt vmcnt(0)" ::: "memory");
        } else {
            XB_SPIN(xb_ld(&bar[XB_XGEN(b.x)]) == gen, bar);
            __builtin_amdgcn_fence(__ATOMIC_ACQUIRE, "agent");
            asm volatile("s_waitcnt vmcnt(0)" ::: "memory");
        }
    }
    __syncthreads();
}

struct Frame {
    LAS unsigned char* lds;
    volatile LAS unsigned* MISC;
    gu32* ctl;
    int tid, lane, wave;
    int vcu, G;
    const float *x, *p, *g_mix, *w_in, *conv_w, *a_log, *dt_bias, *rel_bias, *w_onorm, *w_a, *w_b, *w_out, *g_ffn, *w_gu, *w_dn, *g_ple, *w_pg, *w_pp, *g_final;
    float* out;
    bf16 *Win_t, *Wa_t, *Wb_t, *Wo_t, *Wgu_t, *Wdn_t, *Wpg_t, *Wpp_t;
    float *BD, *SSQ1, *SSQ2, *EGL, *X;
    bf16 *PB, *RA, *PROJ, *HFF, *PP, *TA, *MERGED, *DU, *DNWK, *DQG, *DKDT, *DPQK;
};

template <int CTRL> __device__ __forceinline__ float dppf(float v) { return __builtin_bit_cast(float, __builtin_amdgcn_update_dpp(0, __builtin_bit_cast(int, v), CTRL, 0xf, 0xf, true)); }
__device__ __forceinline__ float row16_sum(float v) {
    v += dppf<0xB1>(v); v += dppf<0x4E>(v); v += dppf<0x141>(v); v += dppf<0x140>(v); return v;
}
__device__ __forceinline__ float half_swap_sum(float v) {
    const auto r = __builtin_amdgcn_permlane32_swap(__float_as_uint(v), __float_as_uint(v), false, false); return __uint_as_float(r[0]) + __uint_as_float(r[1]);
}
__device__ __forceinline__ float wave_sum(float v) {
    v = row16_sum(v);
    { const auto r = __builtin_amdgcn_permlane16_swap(__float_as_uint(v), __float_as_uint(v), false, false); v = __uint_as_float(r[0]) + __uint_as_float(r[1]); }
    return half_swap_sum(v);
}
__device__ __forceinline__ float sigm_(float x) { return __builtin_amdgcn_rcpf(1.0f + __builtin_amdgcn_exp2f(-1.4426950408889634f * x)); }

__device__ __forceinline__ void p0_transpose_blk(const float* W, int K, int Nsrc, bf16* WT, const float* g, int k0, int ns0, int nd0, LAS float* scr, int lane, int ldw = 0) {
    if (ldw == 0) ldw = K;
    const int n4 = (lane & 7) * 4, kr = lane >> 3;
    f32x4 w[8];
#pragma unroll
    for (int i = 0; i < 8; ++i) w[i] = __builtin_nontemporal_load((const f32x4*)(W + (size_t)(k0 + kr + 8 * i) * Nsrc + ns0 + n4));
#pragma unroll
    for (int i = 0; i < 8; ++i) { const int kk = kr + 8 * i; const float gs = g ? g[k0 + kk] : 1.f; LAS float* d = scr + kk * 33 + n4;
        d[0] = w[i][0] * gs; d[1] = w[i][1] * gs; d[2] = w[i][2] * gs; d[3] = w[i][3] * gs; }
    LDS_WAIT(); asm volatile("" ::: "memory");
    const int c = lane & 7;
#pragma unroll
    for (int j = 0; j < 4; ++j) { const int n = (lane >> 3) + 8 * j; const LAS float* s = scr + (8 * c) * 33 + n;
        v4u o; o.x = pk2(s[0 * 33], s[1 * 33]); o.y = pk2(s[2 * 33], s[3 * 33]); o.z = pk2(s[4 * 33], s[5 * 33]); o.w = pk2(s[6 * 33], s[7 * 33]);
        *(GAS v4u*)(WT + (size_t)(nd0 + n) * ldw + k0 + 8 * c) = o; }
    LDS_WAIT(); asm volatile("" ::: "memory");
}

template <int WHICH> __device__ __forceinline__ void late_weights_q(Frame& F) {
    LAS float* scr = (LAS float*)(F.lds + RING_OFF + F.wave * 16384);
    const int lane = lane_id();
    constexpr int I_GU = 16 * 176, I_DN = 44 * 32, I_PG = 16 * 32, I_PP = 4 * 32, I_PB = 2048;
    constexpr int NITEMS = WHICH == 0 ? I_GU : WHICH == 1 ? I_DN : I_PG + I_PP + I_PB;
    for (;;) {
        if (F.wave == 0 && lane == 0) F.MISC[18] = __hip_atomic_fetch_add((unsigned*)(F.ctl + CW_LATEQ + 64 * WHICH), 1u, RLX_AGENT);
        asm volatile("s_waitcnt lgkmcnt(0)" ::: "memory"); __builtin_amdgcn_s_barrier(); asm volatile("" ::: "memory");
        const unsigned tk = F.MISC[18];
        asm volatile("s_waitcnt lgkmcnt(0)" ::: "memory"); __builtin_amdgcn_s_barrier(); asm volatile("" ::: "memory");
        if ((int)tk * NWAVES >= NITEMS) break;
        int r = (int)tk * NWAVES + F.wave;
        if (r >= NITEMS) continue;
        if (WHICH == 0) { const int kb = r / 176, db = r % 176; const int tile = db >> 3, wi = db & 7; const int ns0 = wi < 4 ? 128 * tile + 32 * wi : DFF + 128 * tile + 32 * (wi - 4);
            p0_transpose_blk(F.w_gu, 1024, 2 * DFF, F.Wgu_t, F.g_ffn, 64 * kb, ns0, 32 * db, scr, lane); }
        else if (WHICH == 1) { const int kb = r / 32, db = r % 32; p0_transpose_blk(F.w_dn, DFF, 1024, F.Wdn_t, nullptr, 64 * kb, 32 * db, 32 * db, scr, lane); }
        else {
            if (r < I_PG) { const int kb = r / 32, db = r % 32; p0_transpose_blk(F.w_pg, 1024, 1024, F.Wpg_t, F.g_ple, 64 * kb, 32 * db, 32 * db, scr, lane); continue; } r -= I_PG;
            if (r < I_PP) { const int kb = r / 32, db = r % 32; p0_transpose_blk(F.w_pp, PLE, 1024, F.Wpp_t, nullptr, 64 * kb, 32 * db, 32 * db, scr, lane); continue; } r -= I_PP;
#pragma unroll
            for (int q = 0; q < 8; ++q) { const size_t i = (size_t)r * 512 + q * 64 + lane; const f32x4 a = __builtin_nontemporal_load((const f32x4*)F.p + 2 * i), b = __builtin_nontemporal_load((const f32x4*)F.p + 2 * i + 1);
                v4u o; o.x = pk2(a[0], a[1]); o.y = pk2(a[2], a[3]); o.z = pk2(b[0], b[1]); o.w = pk2(b[2], b[3]); *((v4u*)F.PB + i) = o; }
        }
    }
}

__device__ __forceinline__ void p0_prologue(Frame& F) {
    LAS float* scr = (LAS float*)(F.lds + RING_OFF + F.wave * 16384);
    const int gw = F.vcu * NWAVES + F.wave, NGW = F.G * NWAVES;
    constexpr int I_IN = 16 * 176, I_A = 8 * 32, I_O = 16 * 32;
    constexpr int NITEMS = I_IN + 2 * I_A + I_O;
    for (int it = gw; it < NITEMS; it += NGW) {
        int r = it;
        if (r < I_IN) { const int kb = r / 176, db = r % 176; const int ns0 = db < 96 ? 32 * db : (db < 160 ? 32 * (db - 96) + 3592 : 32 * (db - 160) + 3072); p0_transpose_blk(F.w_in, 1024, DIN, F.Win_t, nullptr, 64 * kb, ns0, 32 * db, scr, F.lane); continue; } r -= I_IN;
        if (r < I_A) { const int kb = r / 32, db = r % 32; p0_transpose_blk(F.w_a, 512, 1024, F.Wa_t, nullptr, 64 * kb, 32 * db, 32 * db, scr, F.lane, 1024); continue; } r -= I_A;
        if (r < I_A) { const int kb = r / 32, db = r % 32; p0_transpose_blk(F.w_b, 512, 1024, F.Wa_t + 512, nullptr, 64 * kb, 32 * db, 32 * db, scr, F.lane, 1024); continue; } r -= I_A;
        { const int kb = r / 32, db = r % 32; p0_transpose_blk(F.w_out, 1024, 1024, F.Wo_t, nullptr, 64 * kb, 32 * db, 32 * db, scr, F.lane); }
    }
    {
        __syncthreads();
        LAS float* wl = (LAS float*)(F.lds + RING_OFF);
        for (int k = F.tid; k < DM; k += NWAVES * 64) { const float* wr_ = F.w_in + (size_t)k * DIN + 3584; const f32x4 a = *(const f32x4*)wr_, b = *(const f32x4*)(wr_ + 4);
            wl[0 * DM + k] = a[0]; wl[1 * DM + k] = a[1]; wl[2 * DM + k] = a[2]; wl[3 * DM + k] = a[3]; wl[4 * DM + k] = b[0]; wl[5 * DM + k] = b[1]; wl[6 * DM + k] = b[2]; wl[7 * DM + k] = b[3]; }
        __syncthreads();
        f32x4 gm[4], wbd[8][4];
#pragma unroll
        for (int j = 0; j < 4; ++j) { gm[j] = *((const GAS f32x4*)F.g_mix + F.lane + 64 * j);
#pragma unroll
            for (int q = 0; q < 8; ++q) wbd[q][j] = *((const LAS f32x4*)(wl + q * DM) + F.lane + 64 * j); }
        f32x4 v[4], vn[4];
        { const GAS f32x4* xr = (const GAS f32x4*)(F.x + (size_t)gw * DM) + F.lane;
#pragma unroll
            for (int j = 0; j < 4; ++j) vn[j] = __builtin_nontemporal_load(xr + 64 * j); }
        for (int m = gw; m < M; m += NGW) {
#pragma unroll
            for (int j = 0; j < 4; ++j) v[j] = vn[j];
            if (m + NGW < M) { const GAS f32x4* xr = (const GAS f32x4*)(F.x + (size_t)(m + NGW) * DM) + F.lane;
#pragma unroll
                for (int j = 0; j < 4; ++j) vn[j] = __builtin_nontemporal_load(xr + 64 * j); }
            float s = 0.f;
#pragma unroll
            for (int j = 0; j < 4; ++j) s += (v[j].x * v[j].x + v[j].y * v[j].y) + (v[j].z * v[j].z + v[j].w * v[j].w);
            const float rstd = __builtin_amdgcn_rsqf(wave_sum(s) * (1.f / DM) + EPS);
            GAS unsigned long long* o8 = (GAS unsigned long long*)(F.RA + (size_t)m * DM) + F.lane;
            float d[8] = {0.f, 0.f, 0.f, 0.f, 0.f, 0.f, 0.f, 0.f};
#pragma unroll
            for (int j = 0; j < 4; ++j) { v[j] = v[j] * rstd * gm[j];
                o8[64 * j] = (unsigned long long)pk2(v[j].x, v[j].y) | ((unsigned long long)pk2(v[j].z, v[j].w) << 32);
#pragma unroll
                for (int q = 0; q < 8; ++q) d[q] += (v[j].x * wbd[q][j][0] + v[j].y * wbd[q][j][1]) + (v[j].z * wbd[q][j][2] + v[j].w * wbd[q][j][3]); }
#pragma unroll
            for (int q = 0; q < 8; ++q) d[q] = wave_sum(d[q]);
            if (F.lane == 0) { *(f32x4*)(F.BD + (size_t)m * 8) = (f32x4){d[0], d[1], d[2], d[3]}; *(f32x4*)(F.BD + (size_t)m * 8 + 4) = (f32x4){d[4], d[5], d[6], d[7]}; }
        }
    }
}

namespace att {
typedef short bf16x8 __attribute__((ext_vector_type(8)));
typedef short s16x4 __attribute__((ext_vector_type(4)));
typedef short v4i16_t __attribute__((ext_vector_type(4)));
typedef float f32x16 __attribute__((ext_vector_type(16)));
typedef float f32x2_t __attribute__((ext_vector_type(2)));
typedef __bf16 bf16x2_t __attribute__((ext_vector_type(2)));
constexpr int SLOTB = 8192, NSLOT = 5, LDS_K = 0, LDS_V = 40960, LDS_BIAS = 81920, LDS_WS = 83968, LDS_OST = 86016;
constexpr float LOG2E = 1.4426950408889634f, C2 = 0.125f * 1.4426950408889634f;
__device__ __forceinline__ int crow(int r, int hi) { return (r & 3) + 8 * (r >> 2) + 4 * hi; }
__device__ __forceinline__ unsigned cvtpk(float lo, float hi) { f32x2_t v = {lo, hi}; bf16x2_t b = __builtin_convertvector(v, bf16x2_t); return __builtin_bit_cast(unsigned, b); }
__device__ __forceinline__ s16x4 vtr(const LAS unsigned char* p) { return __builtin_bit_cast(s16x4, __builtin_amdgcn_ds_read_tr16_b64_v4i16((LAS v4i16_t*)p)); }
__device__ __forceinline__ bf16x8 frag_of(const f32x16& x, int s) { v4u w; w.x = cvtpk(x[8 * s], x[8 * s + 1]); w.y = cvtpk(x[8 * s + 2], x[8 * s + 3]); w.z = cvtpk(x[8 * s + 4], x[8 * s + 5]); w.w = cvtpk(x[8 * s + 6], x[8 * s + 7]); return __builtin_bit_cast(bf16x8, w); }
#define MFMA32(a, b, c) __builtin_amdgcn_mfma_f32_32x32x16_bf16((a), (b), (c), 0, 0, 0)
}

__device__ __forceinline__ void attn_unit(Frame& F, int b, int h, int qg) {
    using namespace att;
    const int tid = F.tid, lane = F.lane, r32 = lane & 31, hi = lane >> 5, wid = F.wave;
    LAS unsigned char* shm = F.lds;
    const int c0 = 4 * qg, cq = c0 + (wid >> 1), qi = (wid & 1) * 32 + r32;
    const size_t rowbase = (size_t)b * SEQ;
    LAS float* biasT = (LAS float*)(shm + LDS_BIAS);
    for (int i = tid; i < NREL; i += NWAVES * 64) biasT[i] = F.rel_bias[h * NREL + i] * LOG2E;
    const bf16* Qrow = F.PROJ + (rowbase + cq * 64 + qi) * NPROJ + C_QA + h * 64;
    bf16x8 qr[4];
#pragma unroll
    for (int d0 = 0; d0 < 4; ++d0) { const v4u w = *(const v4u*)(Qrow + d0 * 16 + hi * 8); v4u o;
        o.x = cvtpk(bflo(w.x) * C2, bfhi(w.x) * C2); o.y = cvtpk(bflo(w.y) * C2, bfhi(w.y) * C2); o.z = cvtpk(bflo(w.z) * C2, bfhi(w.z) * C2); o.w = cvtpk(bflo(w.w) * C2, bfhi(w.w) * C2);
        qr[d0] = __builtin_bit_cast(bf16x8, o); }
    const float bc = F.rel_bias[h * NREL + 256] * LOG2E;
    const int kc_lo = c0 >= 8 ? c0 - 8 : 0, kc_hi = c0 + 3;
    const bf16* ksrc = F.PROJ + (rowbase + 16 * (wid & 3) + (lane >> 2)) * NPROJ + C_KA + h * 64 + (wid >> 2) * 32 + (lane & 3) * 8;
    const bf16* vsrc = F.PROJ + (rowbase + 16 * (wid & 3) + (lane >> 2)) * NPROJ + C_VA + h * 64 + (wid >> 2) * 32 + (lane & 3) * 8;
#define ATT_DMA(kc, slot) do { \
        glds16(ksrc + (size_t)(kc) * 64 * NPROJ, (unsigned)__builtin_amdgcn_readfirstlane(LDS_ADDR(shm + LDS_K + (slot) * SLOTB + wid * 1024))); \
        glds16(vsrc + (size_t)(kc) * 64 * NPROJ, (unsigned)__builtin_amdgcn_readfirstlane(LDS_ADDR(shm + LDS_V + (slot) * SLOTB + wid * 1024))); } while (0)
    float mhat = 0.f; bool first = true;
    f32x16 o0 = {}, o1 = {}, lt = {}, cbm;
#pragma unroll
    for (int r = 0; r < 16; ++r) cbm[r] = bc;
    const bf16x8 ones = {0x3F80, 0x3F80, 0x3F80, 0x3F80, 0x3F80, 0x3F80, 0x3F80, 0x3F80};
    LAS float* wsf = (LAS float*)(shm + LDS_WS) + wid * 64;
    asm volatile("" : "+v"(qr[0]), "+v"(qr[1]), "+v"(qr[2]), "+v"(qr[3]), "+v"(cbm));
    LDS_WAIT();
    ATT_DMA(kc_lo, 0); ATT_DMA(kc_lo + 1, 1); ATT_DMA(kc_lo + 2, 2);
    const bool late = wid >= 4;
    bf16x8 pa0, pa1, pa2, pa3; bool pend = false; int pslot = 0;
    const int vlane = ((lane >> 4) & 1) * 32 + (lane & 3) * 8 + (4 * hi + ((lane & 15) >> 2)) * 64;
#define ATT_VF(d0, ks) ({ const s16x4 lo_ = vtr(vp + (d0) * 4096 + (ks) * 1024), hi_ = vtr(vp + (d0) * 4096 + (ks) * 1024 + 512); (bf16x8){lo_[0], lo_[1], lo_[2], lo_[3], hi_[0], hi_[1], hi_[2], hi_[3]}; })
#define ATT_PV(vslot) do { const LAS unsigned char* vp = shm + LDS_V + (vslot) * SLOTB + vlane; \
        o0 = MFMA32(pa0, ATT_VF(0, 0), o0); o0 = MFMA32(pa1, ATT_VF(0, 1), o0); o0 = MFMA32(pa2, ATT_VF(0, 2), o0); o0 = MFMA32(pa3, ATT_VF(0, 3), o0); \
        o1 = MFMA32(pa0, ATT_VF(1, 0), o1); o1 = MFMA32(pa1, ATT_VF(1, 1), o1); o1 = MFMA32(pa2, ATT_VF(1, 2), o1); o1 = MFMA32(pa3, ATT_VF(1, 3), o1); \
        lt = MFMA32(pa0, ones, lt); lt = MFMA32(pa1, ones, lt); lt = MFMA32(pa2, ones, lt); lt = MFMA32(pa3, ones, lt); } while (0)
    int slot = 0;
#pragma unroll 1
    for (int kc = kc_lo; kc <= kc_hi; ++kc) {
        if (kc + 2 <= kc_hi) asm volatile("s_waitcnt vmcnt(4)" ::: "memory"); else if (kc + 1 <= kc_hi) asm volatile("s_waitcnt vmcnt(2)" ::: "memory"); else asm volatile("s_waitcnt vmcnt(0)" ::: "memory");
        __builtin_amdgcn_s_barrier(); asm volatile("" ::: "memory");
        if (kc + 3 <= kc_hi) ATT_DMA(kc + 3, (slot + 3) % NSLOT);
        if (late && pend) { ATT_PV(pslot); pend = false; }
        if (kc >= cq - 8 && kc <= cq) {
            const LAS unsigned char* kb = shm + LDS_K + slot * SLOTB + (r32 >> 4) * 1024 + (r32 & 15) * 64 + hi * 16;
            const int dist = cq - kc;
            f32x16 p0, p1;
            if (dist >= 3) { p0 = cbm; p1 = cbm; }
            else {
#pragma unroll
                for (int r = 0; r < 16; ++r) { const int kk = crow(r, hi); int r0 = 64 * dist + qi - kk, r1 = r0 - 32;
                    r0 = r0 > 128 ? 128 : r0; r1 = r1 > 128 ? 128 : r1;
                    p0[r] = biasT[r0 + 128] - mhat; p1[r] = biasT[r1 + 128] - mhat; } }
#pragma unroll
            for (int d0 = 0; d0 < 4; ++d0) {
                const bf16x8 b0 = *(const LAS bf16x8*)(kb + (d0 >> 1) * 4096 + (d0 & 1) * 32), b1 = *(const LAS bf16x8*)(kb + (d0 >> 1) * 4096 + (d0 & 1) * 32 + 2048);
                p0 = MFMA32(b0, qr[d0], p0); p1 = MFMA32(b1, qr[d0], p1); }
            float rm = fmaxf(fmaxf(p0[0], p1[0]), fmaxf(p0[1], p1[1]));
#pragma unroll
            for (int r = 2; r < 16; r += 2) rm = fmaxf(rm, fmaxf(fmaxf(p0[r], p1[r]), fmaxf(p0[r + 1], p1[r + 1])));
            { const auto rr_ = __builtin_amdgcn_permlane32_swap(__float_as_uint(rm), __float_as_uint(rm), false, false); rm = fmaxf(__uint_as_float(rr_[0]), __uint_as_float(rr_[1])); }
            if (first || __any(rm > 6.0f)) {
                const float dl = first ? rm : fmaxf(rm, 0.f);
                mhat += dl;
#pragma unroll
                for (int r = 0; r < 16; ++r) { p0[r] -= dl; p1[r] -= dl; cbm[r] = bc - mhat; }
                if (!first) {
                    if (hi == 0) wsf[r32] = __builtin_amdgcn_exp2f(-dl);
                    LDS_WAIT(); asm volatile("" ::: "memory");
#pragma unroll
                    for (int r = 0; r < 16; ++r) { const float a = wsf[crow(r, hi)]; o0[r] *= a; o1[r] *= a; lt[r] *= a; }
                    LDS_WAIT(); asm volatile("" ::: "memory");
                }
                first = false;
            }
#pragma unroll
            for (int r = 0; r < 16; ++r) { p0[r] = __builtin_amdgcn_exp2f(p0[r]); p1[r] = __builtin_amdgcn_exp2f(p1[r]); }
            pa0 = frag_of(p0, 0); pa1 = frag_of(p0, 1); pa2 = frag_of(p1, 0); pa3 = frag_of(p1, 1);
            if (late) { pend = true; pslot = slot; } else { ATT_PV(slot); }
            LDS_WAIT(); asm volatile("" ::: "memory");
        }
        slot = (slot + 1 == NSLOT) ? 0 : slot + 1;
    }
    if (late && pend) { ATT_PV(pslot); LDS_WAIT(); asm volatile("" ::: "memory"); }
    {
        LAS bf16* stg = (LAS bf16*)(shm + LDS_OST) + wid * 2048;
#pragma unroll
        for (int r = 0; r < 16; ++r) { const int orow = crow(r, hi); const float rl = __builtin_amdgcn_rcpf(lt[r]);
            stg[orow * 64 + r32] = (bf16)f2bf(o0[r] * rl); stg[orow * 64 + 32 + r32] = (bf16)f2bf(o1[r] * rl); }
        LDS_WAIT(); asm volatile("" ::: "memory");
        bf16* Ow = F.RA + (rowbase + cq * 64 + (wid & 1) * 32) * DM + h * 64;
#pragma unroll
        for (int i = 0; i < 4; ++i) { const int row = i * 8 + (lane >> 3), ch = lane & 7; const v4u v = *(const LAS v4u*)(stg + row * 64 + ch * 8); *(v4u*)(Ow + (size_t)row * DM + ch * 8) = v; }
    }
    LDS_WAIT(); __builtin_amdgcn_s_barrier(); asm volatile("" ::: "memory");
#undef ATT_DMA
#undef ATT_VF
#undef ATT_PV
}

namespace dn {
using namespace att;
constexpr int IT_K = 0, IT_V = 16384, IT_Q = 32768, IT_GC = 49152, IT_BT = 49152 + 256, IT_BYTES = 51200;
__device__ __forceinline__ int img_off(int l, int f) { return (f >> 5) * 4096 + (l >> 4) * 1024 + (l & 15) * 64 + (f & 31) * 2; }
struct Fr2 { bf16x8 a, b; };
__device__ __forceinline__ Fr2 frs(const f32x16& x) { Fr2 f; f.a = frag_of(x, 0); f.b = frag_of(x, 1); return f; }
__device__ __forceinline__ f32x16 mm(const Fr2& A, const Fr2& B, f32x16 C) { C = MFMA32(A.a, B.a, C); return MFMA32(A.b, B.b, C); }
__device__ __forceinline__ bf16x8 trfrag(const LAS unsigned char* p) { const s16x4 lo_ = vtr(p), hi_ = vtr(p + 512); return (bf16x8){lo_[0], lo_[1], lo_[2], lo_[3], hi_[0], hi_[1], hi_[2], hi_[3]}; }
__device__ __forceinline__ v4u pack8r(const f32x16& x, int s, float sc) { v4u w; w.x = cvtpk(x[8 * s] * sc, x[8 * s + 1] * sc); w.y = cvtpk(x[8 * s + 2] * sc, x[8 * s + 3] * sc); w.z = cvtpk(x[8 * s + 4] * sc, x[8 * s + 5] * sc); w.w = cvtpk(x[8 * s + 6] * sc, x[8 * s + 7] * sc); return w; }
}

__device__ __forceinline__ void dn_prep(Frame& F) {
    using namespace dn;
    const int tid = F.tid, lane = F.lane, r32 = lane & 31, hi = lane >> 5, wid = F.wave, j = wid >> 2, w4 = wid & 3, t256 = tid & 255;
    LAS unsigned char* base = F.lds + j * IT_BYTES;
    LAS float* GC = (LAS float*)(base + IT_GC); LAS float* BT = (LAS float*)(base + IT_BT);
    const LAS unsigned char* Kimg = base + IT_K; const LAS unsigned char* Vimg = base + IT_V; const LAS unsigned char* Qimg = base + IT_Q;
    const int lanepart = ((lane >> 4) & 1) * 32 + (lane & 3) * 8 + (4 * hi + ((lane & 15) >> 2)) * 64;
    LAS float* cwl = (LAS float*)(F.lds + 2 * IT_BYTES);
    for (int i = tid; i < 4 * 1536 / 4; i += NWAVES * 64) ((LAS f32x4*)cwl)[i] = ((const f32x4*)F.conv_w)[i];
#pragma unroll 1
    for (int st = 0; st < 9; ++st) {
        asm volatile("s_waitcnt lgkmcnt(0)" ::: "memory"); __builtin_amdgcn_s_barrier(); asm volatile("" ::: "memory");
        const int ph = st - j; if (ph < 0 || ph >= 8) continue;
        const int iter = ph >> 1; const bool conv_stage = (ph & 1) == 0;
        const int it = (iter * 256 + (F.vcu & 255)) * 2 + j; const int bh = it >> 5, c = it & 31, b = bh >> 2, h = bh & 3; const size_t m0 = (size_t)b * SEQ + (size_t)c * CHK;
        if (conv_stage) {

        {
            const int g = t256 >> 4, c8 = t256 & 15;
            v4u xv[3][7];
#pragma unroll
            for (int part = 0; part < 3; ++part)
#pragma unroll
                for (int k = 0; k < 7; ++k) { const int row = 4 * g - 3 + k;
                    if (c * CHK + row >= 0) xv[part][k] = __builtin_nontemporal_load((const v4u*)(F.PROJ + (size_t)((long)m0 + row) * NPROJ + C_CONV + part * 512 + h * 128 + c8 * 8)); else xv[part][k] = (v4u){0u, 0u, 0u, 0u}; }
#pragma unroll
            for (int part = 0; part < 3; ++part) {
                f32x4 w0[4], w1[4];
#pragma unroll
                for (int i = 0; i < 4; ++i) { const LAS f32x4* wp = (const LAS f32x4*)(cwl + i * 1536 + part * 512 + h * 128 + c8 * 8); w0[i] = wp[0]; w1[i] = wp[1]; }
#pragma unroll
                for (int rr = 0; rr < 4; ++rr) {
                    float acc[8] = {0.f, 0.f, 0.f, 0.f, 0.f, 0.f, 0.f, 0.f};
#pragma unroll
                    for (int i = 0; i < 4; ++i) { const v4u xw = xv[part][rr + i];
                        acc[0] += bflo(xw.x) * w0[i][0]; acc[1] += bfhi(xw.x) * w0[i][1]; acc[2] += bflo(xw.y) * w0[i][2]; acc[3] += bfhi(xw.y) * w0[i][3];
                        acc[4] += bflo(xw.z) * w1[i][0]; acc[5] += bfhi(xw.z) * w1[i][1]; acc[6] += bflo(xw.w) * w1[i][2]; acc[7] += bfhi(xw.w) * w1[i][3]; }
                    float ss = 0.f;
#pragma unroll
                    for (int e = 0; e < 8; ++e) { acc[e] = acc[e] * sigm_(acc[e]); ss += acc[e] * acc[e]; }
                    if (part < 2) { ss = row16_sum(ss);
                        float rn = __builtin_amdgcn_rsqf(ss + EPS); if (part == 0) rn *= 0.08838834764831845f;
#pragma unroll
                        for (int e = 0; e < 8; ++e) acc[e] *= rn; }
                    v4u o; o.x = cvtpk(acc[0], acc[1]); o.y = cvtpk(acc[2], acc[3]); o.z = cvtpk(acc[4], acc[5]); o.w = cvtpk(acc[6], acc[7]);
                    *(LAS v4u*)(base + (part == 0 ? IT_Q : part == 1 ? IT_K : IT_V) + img_off(4 * g + rr, c8 * 8)) = o;
                }
            }
        }
        if (w4 == 0) {
            const size_t m = m0 + lane; const float br = F.BD[m * 8 + h], dr = F.BD[m * 8 + 4 + h] + F.dt_bias[h];
            const float sp = dr > 20.f ? dr : log1pf(expf(dr));
            float cs = -expf(F.a_log[h]) * sp;
#pragma unroll
            for (int o = 1; o < 64; o <<= 1) { const float t = __shfl_up(cs, o); if (lane >= o) cs += t; }
            GC[lane] = cs; BT[lane] = sigm_(br);
            if (lane == 63) F.EGL[it] = expf(cs);
        }
        } else {
        f32x16 kk00 = {}, kk11 = {}, kk10 = {};
#pragma unroll
        for (int s = 0; s < 8; ++s) { const bf16x8 ka = *(const LAS bf16x8*)(Kimg + img_off(r32, 16 * s + 8 * hi)), kb = *(const LAS bf16x8*)(Kimg + img_off(32 + r32, 16 * s + 8 * hi));
            kk00 = MFMA32(ka, ka, kk00); kk11 = MFMA32(kb, kb, kk11); kk10 = MFMA32(kb, ka, kk10); }
        const float gcC0 = GC[r32], gcC1 = GC[32 + r32], bC0 = BT[r32], bC1 = BT[32 + r32];
        f32x16 T11, T11t, T22t, T21t;
        {
            f32x16 P, Pt, T, Tt;
#pragma unroll
            for (int r = 0; r < 16; ++r) { const int rho = crow(r, hi); const float gR = GC[rho], bR = BT[rho];
                const float n = (r32 < rho) ? bR * __expf(gR - gcC0) * kk00[r] : 0.f, nt = (rho < r32) ? bC0 * __expf(gcC0 - gR) * kk00[r] : 0.f;
                const float id = (rho == r32) ? 1.f : 0.f; P[r] = n; Pt[r] = nt; T[r] = id - n; Tt[r] = id - nt; }
#pragma unroll
            for (int n = 0; n < 4; ++n) { Fr2 fP = frs(P), fPt = frs(Pt); const f32x16 z = {};
                P = mm(fPt, fP, z); Pt = mm(fP, fPt, z); fP = frs(P); fPt = frs(Pt);
                const Fr2 fT = frs(T), fTt = frs(Tt); T = mm(fPt, fT, T); Tt = mm(fP, fTt, Tt); }
            T11 = T; T11t = Tt;
        }
        {
            f32x16 P, Pt, Tt;
#pragma unroll
            for (int r = 0; r < 16; ++r) { const int rho = crow(r, hi); const float gR = GC[32 + rho], bR = BT[32 + rho];
                const float n = (r32 < rho) ? bR * __expf(gR - gcC1) * kk11[r] : 0.f, nt = (rho < r32) ? bC1 * __expf(gcC1 - gR) * kk11[r] : 0.f;
                const float id = (rho == r32) ? 1.f : 0.f; P[r] = n; Pt[r] = nt; Tt[r] = id - nt; }
#pragma unroll
            for (int n = 0; n < 4; ++n) { Fr2 fP = frs(P), fPt = frs(Pt); const f32x16 z = {};
                P = mm(fPt, fP, z); Pt = mm(fP, fPt, z); fP = frs(P);
                const Fr2 fTt = frs(Tt); Tt = mm(fP, fTt, Tt); }
            T22t = Tt;
        }
        {
            f32x16 A21;
#pragma unroll
            for (int r = 0; r < 16; ++r) { const int rho = crow(r, hi); A21[r] = BT[32 + rho] * __expf(GC[32 + rho] - gcC0) * kk10[r]; }
            const f32x16 z = {};
            const f32x16 Z = mm(frs(A21), frs(T22t), z);
            const f32x16 t = mm(frs(T11), frs(Z), z);
#pragma unroll
            for (int r = 0; r < 16; ++r) T21t[r] = -t[r];
        }
        {
            f32x16 X11, X21, X22;
#pragma unroll
            for (int r = 0; r < 16; ++r) { const int rho = crow(r, hi); const float b0 = BT[rho], b1 = BT[32 + rho];
                X11[r] = b0 * T11t[r]; X21[r] = b0 * T21t[r]; X22[r] = b1 * T22t[r]; }
            {
                const LAS unsigned char* vb = Vimg + w4 * 4096 + lanepart;
                const bf16x8 v0 = trfrag(vb), v1 = trfrag(vb + 1024), v2 = trfrag(vb + 2048), v3 = trfrag(vb + 3072);
                const Fr2 f11 = frs(X11), f21 = frs(X21), f22 = frs(X22); f32x16 u0 = {}, u1 = {};
                u0 = MFMA32(f11.a, v0, u0); u0 = MFMA32(f11.b, v1, u0);
                u1 = MFMA32(f21.a, v0, u1); u1 = MFMA32(f21.b, v1, u1); u1 = MFMA32(f22.a, v2, u1); u1 = MFMA32(f22.b, v3, u1);
                bf16* up = F.DU + (((size_t)it * 2 + 0) * 4 + w4) * 1024 + lane * 16;
                *(v4u*)(up) = pack8r(u0, 0, 1.f); *(v4u*)(up + 8) = pack8r(u0, 1, 1.f);
                *(v4u*)(up + 4096) = pack8r(u1, 0, 1.f); *(v4u*)(up + 4096 + 8) = pack8r(u1, 1, 1.f);
            }
#pragma unroll
            for (int r = 0; r < 16; ++r) { const int rho = crow(r, hi); const float g0 = __expf(GC[rho]), g1 = __expf(GC[32 + rho]);
                X11[r] *= g0; X21[r] *= g0; X22[r] *= g1; }
            const LAS unsigned char* kb = Kimg + w4 * 4096 + lanepart;
            const bf16x8 k0 = trfrag(kb), k1 = trfrag(kb + 1024), k2 = trfrag(kb + 2048), k3 = trfrag(kb + 3072);
            {
                const Fr2 f11 = frs(X11), f21 = frs(X21), f22 = frs(X22); f32x16 w0 = {}, w1 = {};
                w0 = MFMA32(k0, f11.a, w0); w0 = MFMA32(k1, f11.b, w0);
                w1 = MFMA32(k0, f21.a, w1); w1 = MFMA32(k1, f21.b, w1); w1 = MFMA32(k2, f22.a, w1); w1 = MFMA32(k3, f22.b, w1);
                bf16* wp = F.DNWK + (size_t)it * 8192 + (size_t)r32 * 128 + (2 * w4) * 16 + 8 * hi;
                *(v4u*)(wp) = pack8r(w0, 0, -1.f); *(v4u*)(wp + 16) = pack8r(w0, 1, -1.f);
                *(v4u*)(wp + 32 * 128) = pack8r(w1, 0, -1.f); *(v4u*)(wp + 32 * 128 + 16) = pack8r(w1, 1, -1.f);
            }
            const float glast = GC[63];
            bf16* kd = F.DKDT + (size_t)it * 8192 + (size_t)(32 * w4 + r32) * 64 + 8 * hi;
#pragma unroll
            for (int G = 0; G < 4; ++G) { const bf16x8 kf = G == 0 ? k0 : G == 1 ? k1 : G == 2 ? k2 : k3; v4u w; float e[8];
#pragma unroll
                for (int q = 0; q < 8; ++q) { const int l = 16 * G + 8 * (q >> 2) + 4 * hi + (q & 3); e[q] = bf1((bf16)kf[q]) * __expf(glast - GC[l]); }
                w.x = cvtpk(e[0], e[1]); w.y = cvtpk(e[2], e[3]); w.z = cvtpk(e[4], e[5]); w.w = cvtpk(e[6], e[7]);
                *(v4u*)(kd + G * 16) = w; }
        }
        if (w4 < 3) {
            const int tp = w4 == 2 ? 1 : 0, tl = w4 == 0 ? 0 : 1;
            f32x16 a = {};
#pragma unroll
            for (int s = 0; s < 8; ++s) { const bf16x8 kf = *(const LAS bf16x8*)(Kimg + img_off(32 * tp + r32, 16 * s + 8 * hi)), qf = *(const LAS bf16x8*)(Qimg + img_off(32 * tl + r32, 16 * s + 8 * hi));
                a = MFMA32(kf, qf, a); }
            const int l = 32 * tl + r32; const float gl = GC[l];
#pragma unroll
            for (int r = 0; r < 16; ++r) { const int lp = 32 * tp + crow(r, hi); a[r] = (lp <= l) ? __expf(gl - GC[lp]) * a[r] : 0.f; }
            bf16* pp = F.DPQK + (size_t)it * 4096 + (size_t)l * 64 + (2 * tp) * 16 + 8 * hi;
            *(v4u*)(pp) = pack8r(a, 0, 1.f); *(v4u*)(pp + 16) = pack8r(a, 1, 1.f);
        }
#pragma unroll
        for (int k = 0; k < 2; ++k) { const int pi = lane + 64 * k, row = 16 * w4 + (pi >> 3), grp = pi & 7; const float gm = __expf(GC[row]);
            const v4u a = *(const LAS v4u*)(Qimg + img_off(row, 16 * grp)), bq = *(const LAS v4u*)(Qimg + img_off(row, 16 * grp + 8));
            v4u o0, o1;
            o0.x = cvtpk(bflo(a.x) * gm, bfhi(a.x) * gm); o0.y = cvtpk(bflo(a.y) * gm, bfhi(a.y) * gm); o0.z = cvtpk(bflo(bq.x) * gm, bfhi(bq.x) * gm); o0.w = cvtpk(bflo(bq.y) * gm, bfhi(bq.y) * gm);
            o1.x = cvtpk(bflo(a.z) * gm, bfhi(a.z) * gm); o1.y = cvtpk(bflo(a.w) * gm, bfhi(a.w) * gm); o1.z = cvtpk(bflo(bq.z) * gm, bfhi(bq.z) * gm); o1.w = cvtpk(bflo(bq.w) * gm, bfhi(bq.w) * gm);
            bf16* qp = F.DQG + (size_t)it * 8192 + (size_t)row * 128 + grp * 16; *(v4u*)qp = o0; *(v4u*)(qp + 8) = o1; }
        }
    }
    __syncthreads();
}

__device__ __forceinline__ void dn_scan(Frame& F, int bh) {
    using namespace dn;
    const int lane = F.lane, r32 = lane & 31, hi = lane >> 5, wid = F.wave;
    constexpr int BUF = 57344, B_NWK = 0, B_QG = 16384, B_KDT = 32768, B_PQK = 49152, OB_OFF = 2 * BUF, OB_BYTES = 16384;
    LAS unsigned char* shm = F.lds;
    const int b = bh >> 2, h = bh & 3; const size_t it0 = (size_t)bh * 32;
    if (wid >= 4) {
        const int j = wid - 4;
#define DN_DMA(c, buf) do { const size_t it_ = it0 + (c); LAS unsigned char* d_ = shm + (buf) * BUF; \
        _Pragma("unroll") for (int q = 0; q < 14; ++q) { const int p = j + 4 * q; const unsigned char* src; \
            if (q < 8) { const int pp = p & 15, l = 4 * pp + (lane >> 4), ci = (lane & 15) ^ (l & 15); src = (const unsigned char*)((q < 4 ? F.DNWK : F.DQG) + it_ * 8192) + l * 256 + ci * 16; } \
            else if (q < 12) { const int pp = p - 32, kf = 8 * pp + (lane >> 3), ci = (lane & 7) ^ (kf & 7); src = (const unsigned char*)(F.DKDT + it_ * 8192) + kf * 128 + ci * 16; } \
            else { const int pp = p - 48, l = 8 * pp + (lane >> 3), ci = (lane & 7) ^ (l & 7); src = (const unsigned char*)(F.DPQK + it_ * 4096) + l * 128 + ci * 16; } \
            glds16(src, (unsigned)__builtin_amdgcn_readfirstlane(LDS_ADDR(d_ + p * 1024))); } } while (0)
        DN_DMA(0, 0);
        asm volatile("s_waitcnt vmcnt(0)" ::: "memory"); __builtin_amdgcn_s_barrier(); asm volatile("" ::: "memory");
        const int prow = 16 * j + (lane >> 2), pq = lane & 3;
        v4u zw[4];
#pragma unroll
        for (int i = 0; i < 4; ++i) zw[i] = (v4u){0u, 0u, 0u, 0u};
#pragma unroll 1
        for (int c = 0; c <= 32; ++c) {
            asm volatile("" : "+v"(zw[0]), "+v"(zw[1]), "+v"(zw[2]), "+v"(zw[3]));
            if (c + 1 < 32) DN_DMA(c + 1, (c + 1) & 1);
            v4u zn[4];
            if (c < 32) { const bf16* zp = F.PROJ + ((size_t)b * SEQ + (size_t)c * CHK + prow) * NPROJ + C_Z + h * 128 + 32 * pq;
#pragma unroll
                for (int i = 0; i < 4; ++i) zn[i] = *(const v4u*)(zp + 8 * i); }
            else {
#pragma unroll
                for (int i = 0; i < 4; ++i) zn[i] = (v4u){0u, 0u, 0u, 0u}; }
            if (c >= 1) {
                const LAS unsigned char* ob = shm + OB_OFF + ((c - 1) & 1) * OB_BYTES + prow * 256;
                v4u ow[4]; float ss = 0.f;
#pragma unroll
                for (int i = 0; i < 4; ++i) { ow[i] = *(const LAS v4u*)(ob + (((4 * pq + i) ^ (prow & 15)) << 4));
                    ss += (bflo(ow[i].x) * bflo(ow[i].x) + bfhi(ow[i].x) * bfhi(ow[i].x)) + (bflo(ow[i].y) * bflo(ow[i].y) + bfhi(ow[i].y) * bfhi(ow[i].y))
                        + (bflo(ow[i].z) * bflo(ow[i].z) + bfhi(ow[i].z) * bfhi(ow[i].z)) + (bflo(ow[i].w) * bflo(ow[i].w) + bfhi(ow[i].w) * bfhi(ow[i].w)); }
                ss += dppf<0xB1>(ss); ss += dppf<0x4E>(ss);
                const float rs = __builtin_amdgcn_rsqf(ss * (1.f / 128.f) + EPS);
                bf16* yp = F.RA + ((size_t)b * SEQ + (size_t)(c - 1) * CHK + prow) * DM + 512 + h * 128 + 32 * pq;
#pragma unroll
                for (int i = 0; i < 4; ++i) { v4u y;
                    y.x = cvtpk(bflo(ow[i].x) * rs * bflo(zw[i].x), bfhi(ow[i].x) * rs * bfhi(zw[i].x)); y.y = cvtpk(bflo(ow[i].y) * rs * bflo(zw[i].y), bfhi(ow[i].y) * rs * bfhi(zw[i].y));
                    y.z = cvtpk(bflo(ow[i].z) * rs * bflo(zw[i].z), bfhi(ow[i].z) * rs * bfhi(zw[i].z)); y.w = cvtpk(bflo(ow[i].w) * rs * bflo(zw[i].w), bfhi(ow[i].w) * rs * bfhi(zw[i].w));
                    *(v4u*)(yp + 8 * i) = y; }
            }
            if (c < 32) { asm volatile("s_waitcnt vmcnt(0) lgkmcnt(0)" ::: "memory"); __builtin_amdgcn_s_barrier(); asm volatile("" ::: "memory"); }
#pragma unroll
            for (int i = 0; i < 4; ++i) zw[i] = zn[i];
        }
#undef DN_DMA
    } else {
        const int vt = wid;
        f32x16 st0 = {}, st1 = {}, st2 = {}, st3 = {};
        const bf16* ubase = F.DU + (it0 * 2 * 4 + vt) * 1024 + lane * 16;
        v4u un[4];
        un[0] = *(const v4u*)(ubase); un[1] = *(const v4u*)(ubase + 8); un[2] = *(const v4u*)(ubase + 4096); un[3] = *(const v4u*)(ubase + 4096 + 8);
        const int sw16 = r32 & 15, sw8 = r32 & 7;
        const float egl_all = F.EGL[it0 + (lane & 31)];
        asm volatile("" ::: "memory"); __builtin_amdgcn_s_barrier(); asm volatile("" ::: "memory");
#pragma unroll 1
        for (int c = 0; c < 32; ++c) {
            const LAS unsigned char* bb = shm + (c & 1) * BUF;
            f32x16 W0, W1;
#pragma unroll
            for (int q = 0; q < 4; ++q) { W0[2 * q] = bflo(un[0][q]); W0[2 * q + 1] = bfhi(un[0][q]); W0[8 + 2 * q] = bflo(un[1][q]); W0[9 + 2 * q] = bfhi(un[1][q]);
                W1[2 * q] = bflo(un[2][q]); W1[2 * q + 1] = bfhi(un[2][q]); W1[8 + 2 * q] = bflo(un[3][q]); W1[9 + 2 * q] = bfhi(un[3][q]); }
            if (c + 1 < 32) { const bf16* up = ubase + (size_t)(c + 1) * 8192; un[0] = *(const v4u*)(up); un[1] = *(const v4u*)(up + 8); un[2] = *(const v4u*)(up + 4096); un[3] = *(const v4u*)(up + 4096 + 8); }
            const float egl = __uint_as_float(__builtin_amdgcn_readlane(__float_as_uint(egl_all), c));
            bf16x8 Sf[8];
            Sf[0] = frag_of(st0, 0); Sf[1] = frag_of(st0, 1); Sf[2] = frag_of(st1, 0); Sf[3] = frag_of(st1, 1); Sf[4] = frag_of(st2, 0); Sf[5] = frag_of(st2, 1); Sf[6] = frag_of(st3, 0); Sf[7] = frag_of(st3, 1);
            const LAS unsigned char* nw0 = bb + B_NWK + r32 * 256, *nw1 = nw0 + 32 * 256;
            const LAS unsigned char* qg0 = bb + B_QG + r32 * 256, *qg1 = qg0 + 32 * 256;
            f32x16 O0 = {}, O1 = {};
#pragma unroll
            for (int G = 0; G < 8; ++G) { const int co = ((2 * G + hi) ^ sw16) * 16;
                W0 = MFMA32(*(const LAS bf16x8*)(nw0 + co), Sf[G], W0); W1 = MFMA32(*(const LAS bf16x8*)(nw1 + co), Sf[G], W1);
                O0 = MFMA32(*(const LAS bf16x8*)(qg0 + co), Sf[G], O0); O1 = MFMA32(*(const LAS bf16x8*)(qg1 + co), Sf[G], O1); }
            bf16x8 Wf[4]; Wf[0] = frag_of(W0, 0); Wf[1] = frag_of(W0, 1); Wf[2] = frag_of(W1, 0); Wf[3] = frag_of(W1, 1);
            const LAS unsigned char* pq0 = bb + B_PQK + r32 * 128, *pq1 = pq0 + 32 * 128;
#pragma unroll
            for (int G = 0; G < 2; ++G) O0 = MFMA32(*(const LAS bf16x8*)(pq0 + ((2 * G + hi) ^ sw8) * 16), Wf[G], O0);
#pragma unroll
            for (int G = 0; G < 4; ++G) O1 = MFMA32(*(const LAS bf16x8*)(pq1 + ((2 * G + hi) ^ sw8) * 16), Wf[G], O1);
            const LAS unsigned char* kd = bb + B_KDT + r32 * 128;
            st0 *= egl; st1 *= egl; st2 *= egl; st3 *= egl;
#pragma unroll
            for (int G = 0; G < 4; ++G) { const int co = ((2 * G + hi) ^ sw8) * 16;
                st0 = MFMA32(*(const LAS bf16x8*)(kd + co), Wf[G], st0); st1 = MFMA32(*(const LAS bf16x8*)(kd + 32 * 128 + co), Wf[G], st1);
                st2 = MFMA32(*(const LAS bf16x8*)(kd + 64 * 128 + co), Wf[G], st2); st3 = MFMA32(*(const LAS bf16x8*)(kd + 96 * 128 + co), Wf[G], st3); }
            LAS bf16* ob = (LAS bf16*)(shm + OB_OFF + (c & 1) * OB_BYTES);
#pragma unroll
            for (int r = 0; r < 16; ++r) { const int l = crow(r, hi); const int vs = (32 * vt + r32) ^ ((l & 15) << 3);
                ob[l * 128 + vs] = (bf16)f2bf(O0[r]); ob[(32 + l) * 128 + vs] = (bf16)f2bf(O1[r]); }
            asm volatile("s_waitcnt lgkmcnt(0)" ::: "memory"); __builtin_amdgcn_s_barrier(); asm volatile("" ::: "memory");
        }
    }
    __syncthreads();
}

__device__ __forceinline__ void p3_mix(Frame& F) {
    if ((F.vcu & 3) == 0) dn_scan(F, F.vcu >> 2);
    for (;;) {
        if (F.tid == 0) F.MISC[16] = __hip_atomic_fetch_add((unsigned*)(F.ctl + CW_ATTQ), 1u, RLX_AGENT);
        __syncthreads();
        const unsigned u = F.MISC[16];
        __syncthreads();
        if (u >= 1024u) break;
        int qg, bh;
        if (u < 768u) { qg = 2 + (int)(u >> 7); bh = (int)(u & 127u); } else if (u < 896u) { qg = 1; bh = (int)(u - 768u); } else { qg = 0; bh = (int)(u - 896u); }
        attn_unit(F, bh >> 3, bh & 7, qg);
    }
}

__device__ __forceinline__ void p11_final(Frame& F) {
    const int gw = F.vcu * NWAVES + F.wave, NGW = F.G * NWAVES;
    f32x4 gf[4];
#pragma unroll
    for (int j = 0; j < 2; ++j) { gf[2 * j] = *((const GAS f32x4*)F.g_final + 2 * F.lane + 128 * j); gf[2 * j + 1] = *((const GAS f32x4*)F.g_final + 2 * F.lane + 128 * j + 1); }
    v4u wn[2];
    { const GAS v4u* xr = (const GAS v4u*)(F.HFF + (size_t)gw * DM) + F.lane; wn[0] = xr[0]; wn[1] = xr[64]; }
    for (int m = gw; m < M; m += NGW) {
        const v4u w0 = wn[0], w1 = wn[1];
        if (m + NGW < M) { const GAS v4u* xr = (const GAS v4u*)(F.HFF + (size_t)(m + NGW) * DM) + F.lane; wn[0] = xr[0]; wn[1] = xr[64]; }
        f32x4 v[4];
        v[0] = (f32x4){bflo(w0.x), bfhi(w0.x), bflo(w0.y), bfhi(w0.y)}; v[1] = (f32x4){bflo(w0.z), bfhi(w0.z), bflo(w0.w), bfhi(w0.w)};
        v[2] = (f32x4){bflo(w1.x), bfhi(w1.x), bflo(w1.y), bfhi(w1.y)}; v[3] = (f32x4){bflo(w1.z), bfhi(w1.z), bflo(w1.w), bfhi(w1.w)};
        float s = 0.f;
#pragma unroll
        for (int j = 0; j < 4; ++j) s += (v[j].x * v[j].x + v[j].y * v[j].y) + (v[j].z * v[j].z + v[j].w * v[j].w);
        const float rstd = __builtin_amdgcn_rsqf(wave_sum(s) * (1.f / DM) + EPS);
        GAS f32x4* orow = (GAS f32x4*)(F.out + (size_t)m * DM);
        orow[2 * F.lane] = v[0] * rstd * gf[0]; orow[2 * F.lane + 1] = v[1] * rstd * gf[1];
        orow[128 + 2 * F.lane] = v[2] * rstd * gf[2]; orow[128 + 2 * F.lane + 1] = v[3] * rstd * gf[3];
    }
}

struct Args { const float* in[19]; float* out; unsigned char* ws; int ph_lo, ph_hi, li, pad; };
__global__ void __launch_bounds__(NWAVES * 64, 2) mk_fwd(Args args) {
    extern __shared__ __attribute__((aligned(16))) unsigned char lds[];
    Frame F;
    F.lds = (LAS unsigned char*)lds;
    F.MISC = (volatile LAS unsigned*)(F.lds + MISC_OFF);
    F.tid = threadIdx.x; F.lane = F.tid & 63; F.wave = __builtin_amdgcn_readfirstlane(F.tid >> 6);
    F.G = gridDim.x; { const int bx = blockIdx.x; F.vcu = (F.G % 8 == 0) ? (bx % 8) * (F.G / 8) + bx / 8 : bx; }
#define GRID_BAR(seam) do { if (N_LAUNCHES == PER_PHASE) { if (F.tid == 0) __hip_atomic_store(F.ctl + CW_TMO, 0xBADBA0u | (unsigned)(seam), RLX_AGENT); } \
    else { xcd_barrier(bar); } } while (0)
    unsigned char* ws = args.ws;
    F.ctl = (gu32*)(ws + WS_CTL);
    F.x = args.in[0]; F.p = args.in[1]; F.g_mix = args.in[2]; F.w_in = args.in[3]; F.conv_w = args.in[4]; F.a_log = args.in[5]; F.dt_bias = args.in[6]; F.rel_bias = args.in[7];
    F.w_onorm = args.in[8]; F.w_a = args.in[9]; F.w_b = args.in[10]; F.w_out = args.in[11]; F.g_ffn = args.in[12]; F.w_gu = args.in[13]; F.w_dn = args.in[14]; F.g_ple = args.in[15];
    F.w_pg = args.in[16]; F.w_pp = args.in[17]; F.g_final = args.in[18]; F.out = args.out;
    F.Win_t = (bf16*)(ws + WS_WIN); F.Wa_t = (bf16*)(ws + WS_WA); F.Wb_t = (bf16*)(ws + WS_WB); F.Wo_t = (bf16*)(ws + WS_WO); F.Wgu_t = (bf16*)(ws + WS_WGU);
    F.Wdn_t = (bf16*)(ws + WS_WDN); F.Wpg_t = (bf16*)(ws + WS_WPG); F.Wpp_t = (bf16*)(ws + WS_WPP);
    F.BD = (float*)(ws + WS_BD); F.SSQ1 = (float*)(ws + WS_SSQ1); F.SSQ2 = (float*)(ws + WS_SSQ2); F.EGL = (float*)(ws + WS_EGL); F.X = (float*)(ws + WS_X);
    F.PB = (bf16*)(ws + WS_PB); F.RA = (bf16*)(ws + WS_RA); F.PROJ = (bf16*)(ws + WS_PROJ); F.HFF = (bf16*)(ws + WS_HFF); F.PP = (bf16*)(ws + WS_PP);
    F.MERGED = (bf16*)args.out; F.TA = (bf16*)((unsigned char*)args.out + 64 * MiB);
    F.DU = (bf16*)args.out; F.DNWK = (bf16*)((unsigned char*)args.out + 32 * MiB); F.DQG = (bf16*)((unsigned char*)args.out + 64 * MiB); F.DKDT = (bf16*)((unsigned char*)args.out + 96 * MiB); F.DPQK = (bf16*)(ws + WS_PQK);
    for (int u = F.tid; u < (LDS_BYTES - LDSCTL_OFF) / 4; u += NWAVES * 64) ((LAS unsigned*)(F.lds + LDSCTL_OFF))[u] = 0u;
    __syncthreads();
    const int bli = (N_LAUNCHES == PER_PHASE) ? 0 : args.li;
    XcdBarrier bar; bar.bar = (unsigned*)(F.ctl + CW_BAR) + bli * XCD_BAR_WORDS; bar.x = 0; bar.st = nullptr;
    if (N_LAUNCHES != PER_PHASE) bar = xcd_barrier_post((unsigned*)(F.ctl + CW_BAR) + bli * XCD_BAR_WORDS, F.MISC + 8);

    const int lo = args.ph_lo, hi = args.ph_hi;
#define IN(k) (lo <= (k) && (k) < hi)
#define BOTH(k) (IN(k) && IN((k) + 1))
    using namespace pg8;
#define REFRESH() do { F.lane = lane_id(); F.tid = F.wave * 64 + F.lane; } while (0)
    if (IN(0)) { REFRESH(); p0_prologue(F); if (BOTH(0)) GRID_BAR(0); }
    if (IN(1)) {
        { Gemm g{F.RA, F.Win_t, M, C_Z, DM, DM, DM}; StaticOrder S; S.init(M, C_Z, F.G, (int)blockIdx.x);
          EpiBf16 E{F.PROJ, NPROJ};
          gemm_phase<EpiBf16, StaticOrder, PG8_ALIGN, PG8_SP2>(F.lds + RING_OFF, g, S, E, F.wave); }
        { Gemm g{F.RA, F.Win_t + (size_t)C_Z * DM, M, 512, DM, DM, DM}; StaticOrder S; S.init(M, 512, F.G, (int)blockIdx.x);
          EpiGate E{F.PROJ + C_Z, NPROJ, F.w_onorm};
          gemm_phase<EpiGate, StaticOrder, PG8_ALIGN, PG8_SP2>(F.lds + RING_OFF, g, S, E, F.wave); }
        if (BOTH(1)) GRID_BAR(1);
    }
    if (IN(2)) { REFRESH(); dn_prep(F); if (BOTH(2)) GRID_BAR(2); }
    if (IN(3)) { REFRESH(); p3_mix(F); late_weights_q<0>(F); if (BOTH(3)) GRID_BAR(3); }
    if (IN(4)) {
        Gemm g{F.RA, F.Wa_t, M, DM, DM, DM, DM}; StaticOrder S; S.init(M, DM, F.G, (int)blockIdx.x);
        EpiMergeF E{F.PROJ + C_GA, F.PROJ + C_GB, NPROJ, F.MERGED};
        gemm_phase<EpiMergeF, StaticOrder, PG8_ALIGN, PG8_SP2>(F.lds + RING_OFF, g, S, E, F.wave);
        if (BOTH(4)) GRID_BAR(4);
    }
    if (IN(6)) {
        Gemm g{F.MERGED, F.Wo_t, M, DM, DM, DM, DM}; StaticOrder S; S.init(M, DM, F.G, (int)blockIdx.x);
        EpiRes<false> E{F.x, nullptr, F.RA, F.SSQ1};
        gemm_phase<EpiRes<false>, StaticOrder, PG8_ALIGN, PG8_SP2>(F.lds + RING_OFF, g, S, E, F.wave);
        late_weights_q<1>(F);
        if (BOTH(6)) GRID_BAR(6);
    }
    if (IN(7)) {
        Gemm g{F.RA, F.Wgu_t, M, 2 * DFF, DM, DM, DM}; StaticOrder S; S.init(M, 2 * DFF, F.G, (int)blockIdx.x);
        LAS float* rtab = (LAS float*)(F.lds + 131072);
        { REFRESH();
          for (int e = F.tid; e < 11 * 256; e += NWAVES * 64) { const int ui = e >> 8; Unit uu; if (S.next(ui, uu)) rtab[e] = rstd_from(F.SSQ1, uu.pm * 256 + (e & 255)); }
          __syncthreads(); }
        EpiSwiglu E{rtab, F.HFF, DFF};
        gemm_phase<EpiSwiglu, StaticOrder, PG8_ALIGN, PG8_SP2>(F.lds + RING_OFF, g, S, E, F.wave);
        late_weights_q<2>(F);
        if (BOTH(7)) GRID_BAR(7);
    }
    if (IN(8)) {
        Gemm g{F.HFF, F.Wdn_t, M, DM, DFF, DFF, DFF}; StaticOrder S; S.init(M, DM, F.G, (int)blockIdx.x);
        EpiRes<true> E{nullptr, F.RA, F.RA, F.SSQ2};
        gemm_phase<EpiRes<true>, StaticOrder, PG8_ALIGN, PG8_SP2>(F.lds + RING_OFF, g, S, E, F.wave);
        if (BOTH(8)) GRID_BAR(8);
    }
    if (IN(10)) {
        { Gemm g{F.PB, F.Wpp_t, M, DM, PLE, PLE, PLE}; StaticOrder S; S.init(M, DM, F.G, (int)blockIdx.x);
          EpiBf16 E{F.PP, DM};
          gemm_phase<EpiBf16, StaticOrder, PG8_ALIGN, PG8_SP2>(F.lds + RING_OFF, g, S, E, F.wave); }
        Gemm g{F.RA, F.Wpg_t, M, DM, DM, DM, DM}; StaticOrder S; S.init(M, DM, F.G, (int)blockIdx.x);
        EpiPleNorm E{F.SSQ2, F.RA, F.PP, F.out, (float*)(ws + WS_SSQ3), (unsigned*)(F.ctl + CW_PANEL), F.g_final};
        gemm_phase<EpiPleNorm, StaticOrder, PG8_ALIGN, PG8_SP2>(F.lds + RING_OFF, g, S, E, F.wave);
    }
#undef IN
#undef BOTH
}

extern "C" void kernel_launch(void* const* d_in, const int* in_sizes, int n_in, void* d_out, int out_size, void* d_ws, size_t ws_size, hipStream_t stream) {
    static int grid = 0;
    if (grid == 0) {
        if (n_in != 19 || in_sizes[0] != M * DM || out_size != M * DM || ws_size < WS_END) { fprintf(stderr, "kernel_launch: unexpected shapes: n_in %d in0 %d out %d ws %zu\n", n_in, n_in > 0 ? in_sizes[0] : -1, out_size, ws_size); grid = -1; return; }
        int dev = 0, cus = 0;
        if (hipGetDevice(&dev) != hipSuccess || hipDeviceGetAttribute(&cus, hipDeviceAttributeMultiprocessorCount, dev) != hipSuccess) { grid = -1; return; }
        if (hipFuncSetAttribute((const void*)mk_fwd, hipFuncAttributeMaxDynamicSharedMemorySize, LDS_BYTES) != hipSuccess) { fprintf(stderr, "kernel_launch: hipFuncSetAttribute failed\n"); grid = -1; return; }
        (void)hipGetLastError();
        grid = cus;
        if (grid != 256) fprintf(stderr, "kernel_launch: %d CUs (built for 256)\n", grid);
    }
    if (grid < 0) return;
    if (hipMemsetAsync((char*)d_ws + WS_CTL, 0, CTL_ZERO_BYTES, stream) != hipSuccess) return;
    Args a{};
    for (int i = 0; i < 19; ++i) a.in[i] = (const float*)d_in[i];
    a.out = (float*)d_out; a.ws = (unsigned char*)d_ws;
    for (int li = 0; li < N_LAUNCHES; ++li) {
        if (N_LAUNCHES == PER_PHASE) { a.ph_lo = li; a.ph_hi = li + 1; } else { a.ph_lo = 0; a.ph_hi = PER_PHASE; }
        a.li = li;
        hipLaunchKernelGGL(mk_fwd, dim3(grid), dim3(NWAVES * 64), LDS_BYTES, stream, a);
        const hipError_t le = hipPeekAtLastError();
        if (le != hipSuccess) { fprintf(stderr, "kernel_launch: launch %d failed: %s\n", li, hipGetErrorName(le)); break; }
    }
}
```
